# Optimizing an MI355X kernel written in HIP

```python
import jax, jax.numpy as jnp
from jax import lax
import numpy as np

D_MODEL = 1024
BATCH = 4
SEQ = 8192
DEPTH = 2

MLA_HEADS = 8
QK_NOPE_DIM = 64
QK_ROPE_DIM = 32
V_HEAD_DIM = 64
Q_LORA_RANK = 384
KV_LORA_RANK = 256
ROPE_THETA = 10000.0
Q_BLOCK = 128
MLA_WIDTH = MLA_HEADS * V_HEAD_DIM
POOL_WINDOWS = (2, 4, 8, 16)
POOL_GROUP_DIM = 64
POOL_WIDTH = len(POOL_WINDOWS) * POOL_GROUP_DIM
SG_HEADS = 4
SG_HEAD_DIM = 64
SG_WIDTH = SG_HEADS * SG_HEAD_DIM
SG_CHUNK = 128
D_MIX = MLA_WIDTH + POOL_WIDTH + SG_WIDTH
IN_COLS = Q_LORA_RANK + KV_LORA_RANK + QK_ROPE_DIM + POOL_WIDTH + 2 * SG_WIDTH
D_FF = -(-(8 * D_MODEL) // (3 * 256)) * 256
EPS = 1e-6

kernel_name = "hybrid_mla_pool_sgmlp_encoder"


def rmsnorm(x, g):
    xf = x.astype(jnp.float32)
    y = xf * lax.rsqrt(jnp.mean(xf * xf, axis=-1, keepdims=True) + EPS)
    return (y * g.astype(jnp.float32)).astype(x.dtype)


def rope_tables(positions):
    inv_freq = ROPE_THETA ** (-jnp.arange(0, QK_ROPE_DIM, 2, dtype=jnp.float32) / QK_ROPE_DIM)
    ang = positions.astype(jnp.float32)[..., None] * inv_freq
    return jnp.cos(ang), jnp.sin(ang)


def apply_rope(t, cos, sin):
    tf = t.astype(jnp.float32)
    half = QK_ROPE_DIM // 2
    t1, t2 = tf[..., :half], tf[..., half:]
    out = jnp.concatenate([t1 * cos - t2 * sin, t1 * sin + t2 * cos], axis=-1)
    return out.astype(t.dtype)


def mla_mixer(h_q, h_kv, k_rope_in, positions, q_norm_g, kv_norm_g, w_uq, w_ukv):
    B, S, _ = h_q.shape
    cq = rmsnorm(h_q, q_norm_g)
    q = jnp.einsum('bsr,rn->bsn', cq, w_uq).reshape(B, S, MLA_HEADS, QK_NOPE_DIM + QK_ROPE_DIM)
    q_nope, q_rope = q[..., :QK_NOPE_DIM], q[..., QK_NOPE_DIM:]
    ckv = rmsnorm(h_kv, kv_norm_g)
    kv = jnp.einsum('bsr,rn->bsn', ckv, w_ukv).reshape(B, S, MLA_HEADS, QK_NOPE_DIM + V_HEAD_DIM)
    k_nope, v = kv[..., :QK_NOPE_DIM], kv[..., QK_NOPE_DIM:]
    cos, sin = rope_tables(positions)
    q_rope = apply_rope(q_rope, cos[:, :, None, :], sin[:, :, None, :])
    k_rope = apply_rope(k_rope_in, cos, sin)
    scale = (QK_NOPE_DIM + QK_ROPE_DIM) ** -0.5
    nb = S // Q_BLOCK

    def blockify(t):
        return jnp.moveaxis(t.reshape(B, nb, Q_BLOCK, *t.shape[2:]), 1, 0)

    def attend(blk):
        qn, qr = blk
        s = (jnp.einsum('bqhd,bkhd->bhqk', qn, k_nope)
             + jnp.einsum('bqhr,bkr->bhqk', qr, k_rope))
        p = jax.nn.softmax(s.astype(jnp.float32) * scale, axis=-1).astype(v.dtype)
        return jnp.einsum('bhqk,bkhd->bqhd', p, v)

    o = lax.map(attend, (blockify(q_nope), blockify(q_rope)))
    return jnp.moveaxis(o, 0, 1).reshape(B, S, MLA_WIDTH)


def pool_mixer(h, w_pool, pool_scale):
    B, S, _ = h.shape
    hf = h.astype(jnp.float32)
    cs = jnp.concatenate([jnp.zeros((B, 1, POOL_WIDTH), jnp.float32), lax.cumsum(hf, axis=1)], axis=1)
    t = jnp.arange(S)
    outs = []
    for g, w in enumerate(POOL_WINDOWS):
        left = w // 2
        right = w - 1 - left
        lo = jnp.clip(t - left, 0, S)
        hi = jnp.clip(t + right + 1, 0, S)
        sl = slice(g * POOL_GROUP_DIM, (g + 1) * POOL_GROUP_DIM)
        csg = cs[:, :, sl]
        mean = (csg[:, hi] - csg[:, lo]) / (hi - lo).astype(jnp.float32)[None, :, None]
        d = (mean - hf[:, :, sl]).astype(h.dtype)
        outs.append(jnp.einsum('bsc,cd->bsd', d, w_pool[g]))
    return jnp.concatenate(outs, axis=-1) * pool_scale


def sg_mixer(h_uv, sg_norm_g, w_s, b_s):
    B, S, _ = h_uv.shape
    z = jax.nn.gelu(h_uv)
    u, v = z[..., :SG_WIDTH], z[..., SG_WIDTH:]
    v = rmsnorm(v.reshape(B, S, SG_HEADS, SG_HEAD_DIM), sg_norm_g.reshape(SG_HEADS, SG_HEAD_DIM))
    vc = v.reshape(B, S // SG_CHUNK, SG_CHUNK, SG_HEADS, SG_HEAD_DIM)
    mixed = jnp.einsum('gpq,bcqgd->bcpgd', w_s, vc) + b_s.T[None, None, :, :, None]
    return u * mixed.reshape(B, S, SG_WIDTH)


def setup_inputs(seed: int = 0) -> dict:
    key = jax.random.key(seed)
    ks = jax.random.split(key, 20)
    f32 = jnp.float32

    def nrm(k, shape, fan_in):
        return jax.random.normal(k, shape, f32) * (fan_in ** -0.5)

    def gain(k, shape):
        return 1.0 + 0.05 * jax.random.normal(k, shape, f32)

    x = jax.random.normal(ks[0], (BATCH, SEQ, D_MODEL), f32)
    positions = jnp.broadcast_to(jnp.arange(SEQ, dtype=jnp.int32), (BATCH, SEQ))
    return {
        "x": x,
        "positions": positions,
        "mix_norm": gain(ks[1], (DEPTH, D_MODEL)),
        "w_in": nrm(ks[2], (DEPTH, D_MODEL, IN_COLS), D_MODEL),
        "q_norm": gain(ks[3], (DEPTH, Q_LORA_RANK)),
        "kv_norm": gain(ks[4], (DEPTH, KV_LORA_RANK)),
        "w_uq": nrm(ks[5], (DEPTH, Q_LORA_RANK, MLA_HEADS * (QK_NOPE_DIM + QK_ROPE_DIM)), Q_LORA_RANK),
        "w_ukv": nrm(ks[6], (DEPTH, KV_LORA_RANK, MLA_HEADS * (QK_NOPE_DIM + V_HEAD_DIM)), KV_LORA_RANK),
        "w_pool": nrm(ks[7], (DEPTH, len(POOL_WINDOWS), POOL_GROUP_DIM, POOL_GROUP_DIM), POOL_GROUP_DIM),
        "pool_scale": gain(ks[8], (DEPTH, POOL_WIDTH)),
        "sg_norm": gain(ks[9], (DEPTH, SG_WIDTH)),
        "w_s": nrm(ks[10], (DEPTH, SG_HEADS, SG_CHUNK, SG_CHUNK), SG_CHUNK),
        "b_s": 1.0 + 0.05 * jax.random.normal(ks[11], (DEPTH, SG_HEADS, SG_CHUNK), f32),
        "w_o": nrm(ks[12], (DEPTH, D_MIX, D_MODEL), D_MIX),
        "ffn_norm": gain(ks[13], (DEPTH, D_MODEL)),
        "w_gate": nrm(ks[14], (DEPTH, D_MODEL, D_FF), D_MODEL),
        "w_up": nrm(ks[15], (DEPTH, D_MODEL, D_FF), D_MODEL),
        "w_down": nrm(ks[16], (DEPTH, D_FF, D_MODEL), D_FF),
        "final_norm": gain(ks[17], (D_MODEL,)),
    }


def reference(x, positions, mix_norm, w_in, q_norm, kv_norm, w_uq, w_ukv, w_pool, pool_scale,
              sg_norm, w_s, b_s, w_o, ffn_norm, w_gate, w_up, w_down, final_norm):
    o1 = Q_LORA_RANK
    o2 = o1 + KV_LORA_RANK
    o3 = o2 + QK_ROPE_DIM
    o4 = o3 + POOL_WIDTH
    for l in range(DEPTH):
        h = rmsnorm(x, mix_norm[l])
        p = jnp.einsum('bsd,dn->bsn', h, w_in[l])
        a = mla_mixer(p[..., :o1], p[..., o1:o2], p[..., o2:o3], positions,
                      q_norm[l], kv_norm[l], w_uq[l], w_ukv[l])
        b = pool_mixer(p[..., o3:o4], w_pool[l], pool_scale[l])
        c = sg_mixer(p[..., o4:], sg_norm[l], w_s[l], b_s[l])
        mix = jnp.concatenate([a, b, c], axis=-1)
        x = x + jnp.einsum('bsn,nd->bsd', mix, w_o[l])
        h = rmsnorm(x, ffn_norm[l])
        g = jnp.einsum('bsd,df->bsf', h, w_gate[l])
        u = jnp.einsum('bsd,df->bsf', h, w_up[l])
        x = x + jnp.einsum('bsf,fd->bsd', jax.nn.silu(g) * u, w_down[l])
    return rmsnorm(x, final_norm)
```

```cpp
#include <hip/hip_runtime.h>
#include <hip/hip_cooperative_groups.h>
#include <cstdio>
#include <cstdint>
namespace cg = cooperative_groups;

#ifndef MK_MULTI
#define MK_MULTI 0
#endif

namespace pg8 {
#define PG8_LAS __attribute__((address_space(3)))
typedef unsigned short bf16_t;
typedef short bf16x8 __attribute__((ext_vector_type(8)));
typedef float f32x4 __attribute__((ext_vector_type(4)));
typedef unsigned u32x4 __attribute__((ext_vector_type(4)));
constexpr int BM = 256, BK = 64, HALF = 128, HTB = HALF * BK * 2  , STAGE_BYTES = 8 * HTB, NXCD = 8, WGM = 8;

__host__ __device__ __forceinline__ int lds_byte(int r, int c) { const int st = (r >> 4) * 2 + (c >> 5), rr = r & 15, cc = c & 31, ob = rr * 64 + cc * 2; return st * 1024 + (ob ^ (((ob >> 9) & 1) << 5)); }
__host__ __device__ __forceinline__ void stage_rc(int b, int& R, int& C) { const int st = b / 1024, sb = b % 1024, swz = sb ^ (((sb >> 9) & 1) << 5); R = (st >> 1) * 16 + swz / 64; C = (st & 1) * 32 + (swz % 64) / 2; }
__host__ __device__ __forceinline__ int perm32(int rho) { const int n = rho >> 4, i = rho & 15; return 8 * (i >> 2) + 4 * n + (i & 3); }

struct Unit { int pm, pn; };
struct Gemm { const bf16_t* A; const bf16_t* Bt; int M, N, K; };

struct StaticOrder {
    int nM, nN, nwg, G, c;
    __host__ __device__ void init(int M, int N, int G_, int c_) { nM = M / BM; nN = N / BM; nwg = nM * nN; G = G_; c = c_; }
    __host__ __device__ bool next(int i, Unit& u) const {
        const long L = (long)i * G + c; if (L >= nwg) return false;
        int wgid = (int)L; { const int q = nwg / NXCD, r = nwg % NXCD, xcd = wgid % NXCD, off = wgid / NXCD; wgid = (xcd < r ? xcd * (q + 1) : r * (q + 1) + (xcd - r) * q) + off; }
        const int nig = WGM * nN, gid = wgid / nig, fm = gid * WGM, gsz = (nM - fm) < WGM ? (nM - fm) : WGM;
        u.pm = fm + ((wgid % nig) % gsz); u.pn = (wgid % nig) / gsz; return true;
    }
    __device__ __forceinline__ void a_ready(const Unit&) const {}
    __device__ __forceinline__ void done(const Unit&) const {}
};

__device__ __forceinline__ unsigned cvt_pk_bf16(float lo, float hi) { unsigned r; asm volatile("v_cvt_pk_bf16_f32 %0, %1, %2" : "=v"(r) : "v"(lo), "v"(hi)); return r; }
__device__ __forceinline__ u32x4 pack8(const f32x4 v0, const f32x4 v1) { u32x4 w; w.x = cvt_pk_bf16(v0[0], v0[1]); w.y = cvt_pk_bf16(v0[2], v0[3]); w.z = cvt_pk_bf16(v1[0], v1[1]); w.w = cvt_pk_bf16(v1[2], v1[3]); return w; }
constexpr int SEQ_ = 8192, NH_ = 8;

struct EpiStore {
    static constexpr bool PERM = true, AFTER_DRAIN = false;
    bf16_t* O; int ldc; const float* rss;
    __device__ __forceinline__ void operator()(const f32x4 (&acc)[2][2][4][2], const Unit& u, int wr, int wc, int fr_, int fq_) const {
        int fr = fr_, fq = fq_; asm volatile("" : "+v"(fr), "+v"(fq));
        const int row0 = u.pm * BM + wr * 64 + fr, col0 = u.pn * BM + wc * 32 + 8 * fq;
#pragma unroll
        for (int ai = 0; ai < 2; ++ai)
#pragma unroll
            for (int m = 0; m < 4; ++m) { const int row = row0 + ai * HALF + m * 16; bf16_t* rowp = O + (size_t)row * ldc + col0;
                const float sc = __builtin_amdgcn_rsqf(rss[row] * (1.f / 1024.f) + 1e-6f);
#pragma unroll
                for (int bj = 0; bj < 2; ++bj) *(u32x4*)(rowp + bj * HALF) = pack8(acc[ai][bj][m][0] * sc, acc[ai][bj][m][1] * sc); asm volatile("" ::: "memory"); }
    }
};
struct EpiQ {
    static constexpr bool PERM = true, AFTER_DRAIN = false;
    bf16_t* Q; const float* rope; float c2;
    __device__ __forceinline__ void operator()(const f32x4 (&acc)[2][2][4][2], const Unit& u, int wr, int wc, int fr_, int fq_) const {
        int fr = fr_, fq = fq_; asm volatile("" : "+v"(fr), "+v"(fq));
        const int row0 = u.pm * BM + wr * 64 + fr;
#pragma unroll
        for (int bj = 0; bj < 2; ++bj) {
            const int col = u.pn * BM + bj * HALF + wc * 32 + 8 * fq; const int h = col / 96, j = col - h * 96;
#pragma unroll
            for (int ai = 0; ai < 2; ++ai)
#pragma unroll
                for (int m = 0; m < 4; ++m) {
                    const int row = row0 + ai * HALF + m * 16; const int b = row >> 13, s = row & (SEQ_ - 1);
                    f32x4 v0 = acc[ai][bj][m][0], v1 = acc[ai][bj][m][1];
                    if (j >= 64) {
                        const f32x4* cs = (const f32x4*)(rope + ((size_t)row * 16 + ((j - 64) >> 1)) * 2);
                        const f32x4 c01 = cs[0], c23 = cs[1];
                        f32x4 w0, w1;
                        w0[0] = v0[0] * c01[0] - v0[1] * c01[1]; w0[1] = v0[0] * c01[1] + v0[1] * c01[0];
                        w0[2] = v0[2] * c01[2] - v0[3] * c01[3]; w0[3] = v0[2] * c01[3] + v0[3] * c01[2];
                        w1[0] = v1[0] * c23[0] - v1[1] * c23[1]; w1[1] = v1[0] * c23[1] + v1[1] * c23[0];
                        w1[2] = v1[2] * c23[2] - v1[3] * c23[3]; w1[3] = v1[2] * c23[3] + v1[3] * c23[2];
                        v0 = w0; v1 = w1;
                    }
                    v0 = v0 * c2; v1 = v1 * c2;
                    *(u32x4*)(Q + ((size_t)(b * NH_ + h) * SEQ_ + s) * 96 + j) = pack8(v0, v1); asm volatile("" ::: "memory");
                }
        }
    }
};
struct EpiKV {
    static constexpr bool PERM = true, AFTER_DRAIN = false;
    bf16_t* Kb; bf16_t* Vb;
    __device__ __forceinline__ void operator()(const f32x4 (&acc)[2][2][4][2], const Unit& u, int wr, int wc, int fr_, int fq_) const {
        int fr = fr_, fq = fq_; asm volatile("" : "+v"(fr), "+v"(fq));
        const int row0 = u.pm * BM + wr * 64 + fr;
#pragma unroll
        for (int bj = 0; bj < 2; ++bj) {
            const int col = u.pn * BM + bj * HALF + wc * 32 + 8 * fq; const int h = col >> 7, j = col & 127;
#pragma unroll
            for (int ai = 0; ai < 2; ++ai)
#pragma unroll
                for (int m = 0; m < 4; ++m) {
                    const int row = row0 + ai * HALF + m * 16; const int b = row >> 13, s = row & (SEQ_ - 1);
                    const size_t tok = (size_t)(b * NH_ + h) * SEQ_ + s;
                    bf16_t* dst = (j < 64) ? (Kb + tok * 96 + j) : (Vb + tok * 64 + (j - 64));
                    *(u32x4*)dst = pack8(acc[ai][bj][m][0], acc[ai][bj][m][1]); asm volatile("" ::: "memory");
                }
        }
    }
};
template <bool RESB, bool OUTF, bool STATS> struct EpiRes {
    static constexpr bool PERM = true, AFTER_DRAIN = false;
    const float* res; float* out; int ldc; bf16_t* xb; float* rss;
    __device__ __forceinline__ void operator()(const f32x4 (&acc)[2][2][4][2], const Unit& u, int wr, int wc, int fr_, int fq_) const {
        int fr = fr_, fq = fq_; asm volatile("" : "+v"(fr), "+v"(fq));
        const int row0 = u.pm * BM + wr * 64 + fr, col0 = u.pn * BM + wc * 32 + 8 * fq, lane = fq * 16 + fr;
#pragma unroll
        for (int ai = 0; ai < 2; ++ai)
#pragma unroll
            for (int m = 0; m < 4; ++m) { const int row = row0 + ai * HALF + m * 16; const size_t off = (size_t)row * ldc + col0; float ss = 0.f;
#pragma unroll
                for (int bj = 0; bj < 2; ++bj) {
                    f32x4 r0, r1;
                    if (RESB) { const u32x4 w = *(const u32x4*)(xb + off + bj * HALF);
                        r0[0] = __builtin_bit_cast(float, w.x << 16); r0[1] = __builtin_bit_cast(float, w.x & 0xffff0000u); r0[2] = __builtin_bit_cast(float, w.y << 16); r0[3] = __builtin_bit_cast(float, w.y & 0xffff0000u);
                        r1[0] = __builtin_bit_cast(float, w.z << 16); r1[1] = __builtin_bit_cast(float, w.z & 0xffff0000u); r1[2] = __builtin_bit_cast(float, w.w << 16); r1[3] = __builtin_bit_cast(float, w.w & 0xffff0000u); }
                    else { r0 = *(const f32x4*)(res + off + bj * HALF); r1 = *(const f32x4*)(res + off + bj * HALF + 4); }
                    const f32x4 y0 = r0 + acc[ai][bj][m][0], y1 = r1 + acc[ai][bj][m][1];
                    if (OUTF) { *(f32x4*)(out + off + bj * HALF) = y0; *(f32x4*)(out + off + bj * HALF + 4) = y1; }
                    else *(u32x4*)(xb + off + bj * HALF) = pack8(y0, y1);
                    if (STATS) ss += (y0[0] * y0[0] + y0[1] * y0[1]) + (y0[2] * y0[2] + y0[3] * y0[3]) + (y1[0] * y1[0] + y1[1] * y1[1]) + (y1[2] * y1[2] + y1[3] * y1[3]); }
                if (STATS) {
                    ss += __builtin_bit_cast(float, __builtin_amdgcn_ds_bpermute((lane ^ 16) << 2, __builtin_bit_cast(int, ss)));
                    ss += __builtin_bit_cast(float, __builtin_amdgcn_ds_bpermute((lane ^ 32) << 2, __builtin_bit_cast(int, ss)));
                    if (fq == 0) atomicAdd(rss + row, ss);
                }
                asm volatile("" ::: "memory"); }
    }
};
struct EpiGU {
    static constexpr bool PERM = true, AFTER_DRAIN = false;
    bf16_t* O; int ldc; const float* rss;
    __device__ __forceinline__ void operator()(const f32x4 (&acc)[2][2][4][2], const Unit& u, int wr, int wc, int fr_, int fq_) const {
        int fr = fr_, fq = fq_; asm volatile("" : "+v"(fr), "+v"(fq));
        const int row0 = u.pm * BM + wr * 64 + fr, col0 = u.pn * HALF + wc * 32 + 8 * fq;
#pragma unroll
        for (int ai = 0; ai < 2; ++ai)
#pragma unroll
            for (int m = 0; m < 4; ++m) { const int row = row0 + ai * HALF + m * 16;
                const float sc = __builtin_amdgcn_rsqf(rss[row] * (1.f / 1024.f) + 1e-6f);
                f32x4 o[2];
#pragma unroll
                for (int n = 0; n < 2; ++n)
#pragma unroll
                    for (int j = 0; j < 4; ++j) { const float g = acc[ai][0][m][n][j] * sc, up = acc[ai][1][m][n][j] * sc;
                        o[n][j] = g * __builtin_amdgcn_rcpf(1.f + __builtin_amdgcn_exp2f(-1.4426950408889634f * g)) * up; }
                *(u32x4*)(O + (size_t)row * ldc + col0) = pack8(o[0], o[1]); asm volatile("" ::: "memory");
            }
    }
};

template <class Epi, class Sched, bool ALIGN_EPI = false, bool SP2 = false>
__device__ __forceinline__ void gemm_phase(PG8_LAS unsigned char* lds, const Gemm g, const Sched& S, const Epi& E, const int tid) {
    const int wid = __builtin_amdgcn_readfirstlane(tid >> 6), lane = tid & 63, wr = wid >> 2, wc = wid & 3, fr = lane & 15, fq = lane >> 4;
    const int K = g.K, nt = K / BK;
    unsigned voffA[2], voffB[2];
#pragma unroll
    for (int i = 0; i < 2; ++i) { int R, C; stage_rc(tid * 16 + i * 8192, R, C); const int Rb = Epi::PERM ? ((R & ~31) + perm32(R & 31)) : R;
        voffA[i] = (unsigned)(R * K + C) * 2u; voffB[i] = (unsigned)(Rb * K + C) * 2u; }
    const size_t kstep = (size_t)(BK * 2);
    const size_t hstep = (size_t)HALF * K * 2;
    const size_t tstep = 2 * hstep;
    const unsigned ldsw = (unsigned)wid * 1024u;
    const int aoff = lds_byte(wr * 64 + fr, fq * 8), boff = lds_byte(wc * 32 + fr, fq * 8);
#define PG8_SA(b, h) (((b) * 2 + (h)) * HTB)
#define PG8_SB(b, h) ((4 + (b) * 2 + (h)) * HTB)
#define PG8_STAGE(bufoff, gbase, voff) do { _Pragma("unroll") for (int _i = 0; _i < 2; ++_i) \
        __builtin_amdgcn_global_load_lds((const unsigned*)((const char*)(gbase) + (voff)[_i]), (PG8_LAS unsigned*)(lds + (bufoff) + ldsw + _i * 8192), 16, 0, 0); } while (0)
#define PG8_LDA(dst, b, h) do { _Pragma("unroll") for (int m = 0; m < 4; ++m) _Pragma("unroll") for (int k = 0; k < 2; ++k) dst[m][k] = *(const PG8_LAS bf16x8*)(lds + PG8_SA(b, h) + aoff + m * 2048 + k * 1024); } while (0)
#define PG8_LDB(dst, b, h) do { _Pragma("unroll") for (int n = 0; n < 2; ++n) _Pragma("unroll") for (int k = 0; k < 2; ++k) dst[n][k] = *(const PG8_LAS bf16x8*)(lds + PG8_SB(b, h) + boff + n * 2048 + k * 1024); } while (0)
#define PG8_MMA(ai, bj, At, Bt) do { __builtin_amdgcn_s_setprio(1); _Pragma("unroll") for (int m = 0; m < 4; ++m) _Pragma("unroll") for (int n = 0; n < 2; ++n) _Pragma("unroll") for (int k = 0; k < 2; ++k) \
        acc[ai][bj][m][n] = __builtin_amdgcn_mfma_f32_16x16x32_bf16(Bt[n][k], At[m][k], acc[ai][bj][m][n], 0, 0, 0); __builtin_amdgcn_s_setprio(0); } while (0)
#define PG8_WAIT_V(n) asm volatile("s_waitcnt vmcnt(" #n ")" ::: "memory")
#define PG8_WAIT_L(n) asm volatile("s_waitcnt lgkmcnt(" #n ")" ::: "memory")
#define PG8_BAR __builtin_amdgcn_s_barrier()
#define PG8_SCHED __builtin_amdgcn_sched_barrier(0)
    Unit cur, nxt; int ui = 0;
    if (!S.next(0, cur)) return;
    f32x4 acc[2][2][4][2];
#pragma unroll
    for (int a = 0; a < 2; ++a)
#pragma unroll
        for (int b = 0; b < 2; ++b)
#pragma unroll
            for (int m = 0; m < 4; ++m)
#pragma unroll
                for (int n = 0; n < 2; ++n) acc[a][b][m][n] = (f32x4){0.f, 0.f, 0.f, 0.f};
    bf16x8 At[4][2], B0[2][2], B1[2][2];
    const char* cA = (const char*)g.A + (size_t)cur.pm * tstep; const char* cB = (const char*)g.Bt + (size_t)cur.pn * tstep;
    S.a_ready(cur);
    if constexpr (SP2) {
        PG8_STAGE(PG8_SB(0, 0), cB, voffB); PG8_STAGE(PG8_SB(0, 1), cB + hstep, voffB); PG8_STAGE(PG8_SA(0, 0), cA, voffA); PG8_STAGE(PG8_SA(0, 1), cA + hstep, voffA);
        if (wr == 1) PG8_BAR;
        PG8_WAIT_V(2); PG8_BAR;
        PG8_STAGE(PG8_SB(1, 0), cB + kstep, voffB); PG8_STAGE(PG8_SA(1, 0), cA + kstep, voffA); PG8_STAGE(PG8_SB(1, 1), cB + hstep + kstep, voffB);
        PG8_WAIT_V(6); PG8_BAR;
    } else {
        PG8_STAGE(PG8_SB(0, 0), cB, voffB); PG8_STAGE(PG8_SA(0, 0), cA, voffA); PG8_STAGE(PG8_SB(0, 1), cB + hstep, voffB); PG8_STAGE(PG8_SA(0, 1), cA + hstep, voffA);
        if (wr == 1) PG8_BAR;
        PG8_WAIT_V(4); PG8_BAR;
        PG8_STAGE(PG8_SB(1, 0), cB + kstep, voffB); PG8_STAGE(PG8_SA(1, 0), cA + kstep, voffA); PG8_STAGE(PG8_SB(1, 1), cB + hstep + kstep, voffB);
        PG8_WAIT_V(6); PG8_BAR;
    }
    for (;;) {
        const bool has_next = S.next(ui + 1, nxt);
        const char* nA = has_next ? (const char*)g.A + (size_t)nxt.pm * tstep : cA; const char* nB = has_next ? (const char*)g.Bt + (size_t)nxt.pn * tstep : cB;
#pragma unroll 1
        for (int t = 0; t < nt; t += 2) {
            const bool last = (t == nt - 2);
            const char* a1 = cA + (size_t)(t + 1) * kstep;
            const char* a2 = last ? nA : cA + (size_t)(t + 2) * kstep; const char* b2 = last ? nB : cB + (size_t)(t + 2) * kstep;
            const char* a3 = a2 + kstep; const char* b3 = b2 + kstep;
            if (last && has_next) S.a_ready(nxt);
            if constexpr (SP2) {
            PG8_LDB(B0, 0, 0); PG8_LDB(B1, 0, 1); PG8_SCHED; PG8_LDA(At, 0, 0); PG8_STAGE(PG8_SA(1, 1), a1 + hstep, voffA);
            PG8_WAIT_V(8); PG8_WAIT_L(0); PG8_BAR; PG8_MMA(0, 0, At, B0); PG8_MMA(0, 1, At, B1); PG8_BAR; PG8_SCHED;
            PG8_LDA(At, 0, 1); PG8_STAGE(PG8_SB(0, 0), b2, voffB); PG8_STAGE(PG8_SB(0, 1), b2 + hstep, voffB); PG8_STAGE(PG8_SA(0, 0), a2, voffA);
            PG8_WAIT_V(8); PG8_WAIT_L(0); PG8_BAR; PG8_MMA(1, 0, At, B0); PG8_MMA(1, 1, At, B1); PG8_BAR; PG8_SCHED;
            PG8_LDB(B0, 1, 0); PG8_LDB(B1, 1, 1); PG8_SCHED; PG8_LDA(At, 1, 0); PG8_STAGE(PG8_SA(0, 1), a2 + hstep, voffA);
            PG8_WAIT_V(8); PG8_WAIT_L(0); PG8_BAR; PG8_MMA(0, 0, At, B0); PG8_MMA(0, 1, At, B1); PG8_BAR; PG8_SCHED;
            PG8_LDA(At, 1, 1); PG8_STAGE(PG8_SB(1, 0), b3, voffB); PG8_STAGE(PG8_SB(1, 1), b3 + hstep, voffB); PG8_STAGE(PG8_SA(1, 0), a3, voffA);
            PG8_WAIT_V(8); PG8_WAIT_L(0); PG8_BAR; PG8_MMA(1, 0, At, B0); PG8_MMA(1, 1, At, B1); PG8_BAR; PG8_SCHED;
            } else {
            PG8_LDB(B0, 0, 0); PG8_SCHED; PG8_LDA(At, 0, 0); PG8_STAGE(PG8_SA(1, 1), a1 + hstep, voffA);
            PG8_WAIT_L(8); PG8_BAR; PG8_WAIT_L(0); PG8_MMA(0, 0, At, B0); PG8_BAR; PG8_SCHED;
            PG8_LDB(B1, 0, 1); PG8_STAGE(PG8_SB(0, 0), b2, voffB);
            PG8_BAR; PG8_WAIT_L(0); PG8_MMA(0, 1, At, B1); PG8_BAR;
            PG8_LDA(At, 0, 1); PG8_STAGE(PG8_SA(0, 0), a2, voffA);
            PG8_BAR; PG8_WAIT_L(0); PG8_MMA(1, 0, At, B0); PG8_BAR; PG8_SCHED;
            PG8_STAGE(PG8_SB(0, 1), b2 + hstep, voffB);
            PG8_WAIT_V(6); PG8_BAR; PG8_MMA(1, 1, At, B1); PG8_BAR;
            PG8_LDB(B0, 1, 0); PG8_SCHED; PG8_LDA(At, 1, 0); PG8_STAGE(PG8_SA(0, 1), a2 + hstep, voffA);
            PG8_WAIT_L(8); PG8_BAR; PG8_WAIT_L(0); PG8_MMA(0, 0, At, B0); PG8_BAR; PG8_SCHED;
            PG8_LDB(B1, 1, 1); PG8_STAGE(PG8_SB(1, 0), b3, voffB);
            PG8_BAR; PG8_WAIT_L(0); PG8_MMA(0, 1, At, B1); PG8_BAR;
            PG8_LDA(At, 1, 1); PG8_STAGE(PG8_SA(1, 0), a3, voffA);
            PG8_BAR; PG8_WAIT_L(0); PG8_MMA(1, 0, At, B0); PG8_BAR; PG8_SCHED;
            PG8_STAGE(PG8_SB(1, 1), b3 + hstep, voffB);
            PG8_WAIT_V(6); PG8_BAR; PG8_MMA(1, 1, At, B1); PG8_BAR;
            }
        }
        if constexpr (ALIGN_EPI) { if (wr == 0) PG8_BAR; }
        if constexpr (!Epi::AFTER_DRAIN) { E(acc, cur, wr, wc, fr, fq); S.done(cur); }
        if (!has_next) break;
#pragma unroll
        for (int a = 0; a < 2; ++a)
#pragma unroll
            for (int b = 0; b < 2; ++b)
#pragma unroll
                for (int m = 0; m < 4; ++m)
#pragma unroll
                    for (int n = 0; n < 2; ++n) acc[a][b][m][n] = (f32x4){0.f, 0.f, 0.f, 0.f};
        cur = nxt; cA = nA; cB = nB; ++ui;
        if constexpr (ALIGN_EPI) { if (wr == 1) PG8_BAR; }
    }
    PG8_WAIT_V(0);
    if constexpr (!ALIGN_EPI) { if (wr == 0) PG8_BAR; }
    PG8_BAR;
    if constexpr (Epi::AFTER_DRAIN) { E.fused(acc, cur, wr, wc, fr, fq, lds, wid, lane); S.done(cur); }
#undef PG8_SA
#undef PG8_SB
#undef PG8_STAGE
#undef PG8_LDA
#undef PG8_LDB
#undef PG8_MMA
#undef PG8_WAIT_V
#undef PG8_WAIT_L
#undef PG8_BAR
#undef PG8_SCHED
}
}

#define LAS __attribute__((address_space(3)))
typedef unsigned short bf16;
typedef short bf16x8 __attribute__((ext_vector_type(8)));
typedef short s16x4 __attribute__((ext_vector_type(4)));
typedef float f32x4 __attribute__((ext_vector_type(4)));
typedef float f32x2 __attribute__((ext_vector_type(2)));
typedef float f32x16 __attribute__((ext_vector_type(16)));
typedef unsigned u32x4 __attribute__((ext_vector_type(4)));
typedef unsigned u32x2 __attribute__((ext_vector_type(2)));
#define LDS_WAIT() asm volatile("s_waitcnt lgkmcnt(0)" ::: "memory")
#define SBAR() __builtin_amdgcn_sched_barrier(0)
__device__ __forceinline__ unsigned cvtpk(float lo, float hi) { unsigned r; asm volatile("v_cvt_pk_bf16_f32 %0, %1, %2" : "=v"(r) : "v"(lo), "v"(hi)); return r; }
__device__ __forceinline__ float bf2f(unsigned short h) { return __builtin_bit_cast(float, (unsigned)h << 16); }
__device__ __forceinline__ float bflo(unsigned w) { return __builtin_bit_cast(float, w << 16); }
__device__ __forceinline__ float bfhi(unsigned w) { return __builtin_bit_cast(float, w & 0xffff0000u); }
__device__ __forceinline__ void unpack8(const u32x4 w, float* f) { f[0] = bflo(w.x); f[1] = bfhi(w.x); f[2] = bflo(w.y); f[3] = bfhi(w.y); f[4] = bflo(w.z); f[5] = bfhi(w.z); f[6] = bflo(w.w); f[7] = bfhi(w.w); }
__device__ __forceinline__ u32x4 pack8f(const float* f) { u32x4 w; w.x = cvtpk(f[0], f[1]); w.y = cvtpk(f[2], f[3]); w.z = cvtpk(f[4], f[5]); w.w = cvtpk(f[6], f[7]); return w; }
__device__ __forceinline__ float shx(float v, int lane, int m) { return __builtin_bit_cast(float, __builtin_amdgcn_ds_bpermute((lane ^ m) << 2, __builtin_bit_cast(int, v))); }
__device__ __forceinline__ float wave_sum(float v, int lane) {
#pragma unroll
    for (int o = 1; o < 64; o <<= 1) v += shx(v, lane, o);
    return v;
}
__device__ __forceinline__ float gelu_tanh(float x) {
    const float y = 0.7978845608028654f * (x + 0.044715f * x * x * x);
    return x * __builtin_amdgcn_rcpf(1.f + __builtin_amdgcn_exp2f(-2.f * 1.4426950408889634f * y));
}

namespace att {
constexpr int NW = 8, QBLK = 32, KVBLK = 64, SEQ = 8192;
constexpr int KROW = 208;
constexpr int SHM_V = KVBLK * 64 * 2, SHM_K = KVBLK * KROW;
constexpr int LDS_V = 0, LDS_K = 3 * SHM_V, LDS_WS = LDS_K + 3 * SHM_K, LDS_BYTES = LDS_WS + NW * 64 * 4;
constexpr float THR2 = 11.5f;
__device__ __forceinline__ int crow(int r, int hi) { return (r & 3) + 8 * (r >> 2) + 4 * hi; }

__device__ __forceinline__ void partialSM(f32x16& p0, f32x16& p1, float& m_reg, float& mn, float& alpha) {
  float pmax = p0[0];
#pragma unroll
  for (int r = 1; r < 16; ++r) pmax = fmaxf(pmax, p0[r]);
#pragma unroll
  for (int r = 0; r < 16; ++r) pmax = fmaxf(pmax, p1[r]);
  { auto rr = __builtin_amdgcn_permlane32_swap(__float_as_uint(pmax), __float_as_uint(pmax), false, false);
    pmax = fmaxf(__uint_as_float(rr[0]), __uint_as_float(rr[1])); }
  if (__builtin_expect(__all(pmax - m_reg <= THR2), 1)) { mn = m_reg; alpha = 1.f; }
  else { mn = fmaxf(m_reg, pmax); alpha = __builtin_amdgcn_exp2f(m_reg - mn); m_reg = mn; }
#pragma unroll
  for (int r = 0; r < 16; ++r) p0[r] = p0[r] - mn;
#pragma unroll
  for (int r = 0; r < 16; ++r) p1[r] = p1[r] - mn;
#pragma unroll
  for (int r = 0; r < 16; ++r) p0[r] = __builtin_amdgcn_exp2f(p0[r]);
}
__device__ __forceinline__ void finishSM(f32x16& p0, f32x16& p1, float alpha, float& l_reg, bf16x8& pa0, bf16x8& pa1, bf16x8& pa2, bf16x8& pa3) {
#pragma unroll
  for (int r = 0; r < 16; ++r) p1[r] = __builtin_amdgcn_exp2f(p1[r]);
  float ps = 0;
#pragma unroll
  for (int r = 0; r < 16; ++r) ps += p0[r];
#pragma unroll
  for (int r = 0; r < 16; ++r) ps += p1[r];
  { auto rr = __builtin_amdgcn_permlane32_swap(__float_as_uint(ps), __float_as_uint(ps), false, false);
    ps = __uint_as_float(rr[0]) + __uint_as_float(rr[1]); }
  l_reg = l_reg * alpha + ps;
#define PK4(P, BASE, OUT) do { unsigned a0 = cvtpk(P[BASE + 0], P[BASE + 1]), a1 = cvtpk(P[BASE + 2], P[BASE + 3]);   \
    unsigned b0 = cvtpk(P[BASE + 4], P[BASE + 5]), b1 = cvtpk(P[BASE + 6], P[BASE + 7]);                              \
    auto r0 = __builtin_amdgcn_permlane32_swap(a0, b0, false, false); auto r1 = __builtin_amdgcn_permlane32_swap(a1, b1, false, false); \
    u32x4 w = {r0[0], r1[0], r0[1], r1[1]}; OUT = *reinterpret_cast<bf16x8*>(&w); } while (0)
  PK4(p0, 0, pa0); PK4(p0, 8, pa1); PK4(p1, 0, pa2); PK4(p1, 8, pa3);
#undef PK4
}
__device__ __forceinline__ void qkt(f32x16& p0, f32x16& p1, const char* Ks, const bf16x8* qr, int r32, int hi) {
  p0 = f32x16{}; p1 = f32x16{};
#pragma unroll
  for (int d0 = 0; d0 < 6; ++d0) { const int cb = d0 * 32 + hi * 16;
    bf16x8 b0 = *reinterpret_cast<const bf16x8*>(Ks + r32 * KROW + cb);
    bf16x8 b1 = *reinterpret_cast<const bf16x8*>(Ks + (32 + r32) * KROW + cb);
    p0 = __builtin_amdgcn_mfma_f32_32x32x16_bf16(b0, qr[d0], p0, 0, 0, 0);
    p1 = __builtin_amdgcn_mfma_f32_32x32x16_bf16(b1, qr[d0], p1, 0, 0, 0); }
}
__device__ __forceinline__ int v_st(int k, int c) { const int kk = (k & ~0xC) | ((k & 4) << 1) | ((k & 8) >> 1); return ((kk >> 3) * 2 + (c >> 5)) * 512 + ((kk & 7) * 32 + (c & 31)) * 2; }
__device__ __forceinline__ int v_rd_base(int lane) { return ((lane & 3) << 3) | (((lane >> 2) & 3) << 6) | (((lane >> 4) & 1) << 5) | (((lane >> 5) & 1) << 8); }
constexpr int v_rd_off(int d0, int ks, int half) { return d0 * 512 + ks * 2048 + half * 1024; }
template <int OFF> __device__ __forceinline__ s16x4 tr_read(int vb) {
  s16x4 r; asm volatile("ds_read_b64_tr_b16 %0, %1 offset:%2" : "=&v"(r) : "v"(vb), "i"(OFF) : "memory"); return r;
}
template <int D0> __device__ __forceinline__ void pv_one(f32x16& od, int vb, bf16x8 pa0, bf16x8 pa1, bf16x8 pa2, bf16x8 pa3) {
  const s16x4 l0 = tr_read<v_rd_off(D0, 0, 0)>(vb), h0 = tr_read<v_rd_off(D0, 0, 1)>(vb), l1 = tr_read<v_rd_off(D0, 1, 0)>(vb), h1 = tr_read<v_rd_off(D0, 1, 1)>(vb);
  const s16x4 l2 = tr_read<v_rd_off(D0, 2, 0)>(vb), h2 = tr_read<v_rd_off(D0, 2, 1)>(vb), l3 = tr_read<v_rd_off(D0, 3, 0)>(vb), h3 = tr_read<v_rd_off(D0, 3, 1)>(vb);
  asm volatile("s_waitcnt lgkmcnt(0)" ::: "memory"); SBAR();
#define PK(L, H) (bf16x8){L[0], L[1], L[2], L[3], H[0], H[1], H[2], H[3]}
  od = __builtin_amdgcn_mfma_f32_32x32x16_bf16(pa0, PK(l0, h0), od, 0, 0, 0);
  od = __builtin_amdgcn_mfma_f32_32x32x16_bf16(pa1, PK(l1, h1), od, 0, 0, 0);
  od = __builtin_amdgcn_mfma_f32_32x32x16_bf16(pa2, PK(l2, h2), od, 0, 0, 0);
  od = __builtin_amdgcn_mfma_f32_32x32x16_bf16(pa3, PK(l3, h3), od, 0, 0, 0);
#undef PK
}
__device__ __forceinline__ void pv_d0(f32x16* o, int vb, bf16x8 pa0, bf16x8 pa1, bf16x8 pa2, bf16x8 pa3) {
  pv_one<0>(o[0], vb, pa0, pa1, pa2, pa3); pv_one<1>(o[1], vb, pa0, pa1, pa2, pa3);
}

typedef short v4i16_t __attribute__((ext_vector_type(4)));
__device__ __forceinline__ s16x4 vtr(const LAS char* p) { return __builtin_bit_cast(s16x4, __builtin_amdgcn_ds_read_tr16_b64_v4i16((LAS v4i16_t*)p)); }
template <int VAR> __device__ __forceinline__ void attn_unit(const bf16* __restrict__ Qb, const bf16* __restrict__ Kh, const bf16* __restrict__ Vh, bf16* __restrict__ Ob, int ldo, char* lds, const int tid, const int rot) {
  const int wid = __builtin_amdgcn_readfirstlane(tid >> 6), lane = tid & 63, r32 = lane & 31, hi = lane >> 5, g = wid >> 2;
  LAS char* ldsl = (LAS char*)lds;
  LAS char* V_lds = ldsl + LDS_V; LAS char* K_lds = ldsl + LDS_K;
  LAS float* ws = (LAS float*)(ldsl + LDS_WS) + wid * 64; LAS float* li_l = ws; LAS float* al_l = ws + 32;
  float m_reg = 0.f, l_reg = 0; f32x16 o[2] = {}; bf16x8 qr[6];
  f32x16 negm = f32x16{};
  const bf16* Qw = Qb + (size_t)(wid * QBLK + r32) * 96 + hi * 8;
#pragma unroll
  for (int d0 = 0; d0 < 6; ++d0) qr[d0] = *reinterpret_cast<const bf16x8*>(Qw + d0 * 16);
  const int kst0 = (tid / 12) * KROW + (tid % 12) * 16, kst1 = ((tid + 512) / 12) * KROW + ((tid + 512) % 12) * 16;
  const int vst = v_st(tid >> 3, (tid & 7) * 8);
  const bool k2 = wid < 4;
  const LAS char* kr = K_lds + r32 * KROW + hi * 16;
  const LAS char* vb = V_lds + v_rd_base(lane);
  const char* Kg = (const char*)Kh + tid * 16; const char* Vg = (const char*)Vh + tid * 16;
  bf16x8 sk0, sk1 = bf16x8{}, sv;
#define TROT(t) ((size_t)(((t) + rot) & (SEQ / KVBLK - 1)))
#define LOADK(t) do { sk0 = *reinterpret_cast<const bf16x8*>(Kg + TROT(t) * (KVBLK * 192)); if (k2) sk1 = *reinterpret_cast<const bf16x8*>(Kg + TROT(t) * (KVBLK * 192) + 8192); } while (0)
#define LOADV(t) do { sv = *reinterpret_cast<const bf16x8*>(Vg + TROT(t) * (KVBLK * 128)); } while (0)
#define WRITEK(b) do { *reinterpret_cast<LAS bf16x8*>(K_lds + (b) * SHM_K + kst0) = sk0; if (k2) *reinterpret_cast<LAS bf16x8*>(K_lds + (b) * SHM_K + kst1) = sk1; } while (0)
#define WRITEV(b) do { *reinterpret_cast<LAS bf16x8*>(V_lds + (b) * SHM_V + vst) = sv; } while (0)
  constexpr int NT = SEQ / KVBLK;
  bf16x8 tk0, tk1 = bf16x8{};
  LOADK(0); LOADV(0);
  tk0 = *reinterpret_cast<const bf16x8*>(Kg + TROT(1) * (KVBLK * 192)); if (k2) tk1 = *reinterpret_cast<const bf16x8*>(Kg + TROT(1) * (KVBLK * 192) + 8192);
  WRITEK(0); WRITEV(0);
  *reinterpret_cast<LAS bf16x8*>(V_lds + 2 * SHM_V + vst) = bf16x8{};
  *reinterpret_cast<LAS bf16x8*>(K_lds + 1 * SHM_K + kst0) = tk0; if (k2) *reinterpret_cast<LAS bf16x8*>(K_lds + 1 * SHM_K + kst1) = tk1;
  LOADK(2); LOADV(1);
  __syncthreads();
  if (g == 1) __syncthreads();
  bf16x8 pa0 = bf16x8{}, pa1 = bf16x8{}, pa2 = bf16x8{}, pa3 = bf16x8{};
  int rk = 0, rv = 2;
#pragma unroll 1
  for (int j = 0; j < NT; ++j) {
    f32x16 s0 = negm, s1 = negm;
    {
      const LAS char* kp = kr + rk * SHM_K; const LAS char* vp = vb + rv * SHM_V;
      bf16x8 ka[6], kb[6];
#pragma unroll
      for (int d0 = 0; d0 < 6; ++d0) { ka[d0] = *reinterpret_cast<const LAS bf16x8*>(kp + d0 * 32); kb[d0] = *reinterpret_cast<const LAS bf16x8*>(kp + 32 * KROW + d0 * 32); }
      s16x4 vl[2][4], vh[2][4];
      __builtin_amdgcn_sched_barrier(0);
#pragma unroll
      for (int d0 = 0; d0 < 2; ++d0) {
        s0 = __builtin_amdgcn_mfma_f32_32x32x16_bf16(ka[d0], qr[d0], s0, 0, 0, 0);
        s1 = __builtin_amdgcn_mfma_f32_32x32x16_bf16(kb[d0], qr[d0], s1, 0, 0, 0); }
      __builtin_amdgcn_sched_barrier(0);
#pragma unroll
      for (int ks = 0; ks < 4; ++ks) { vl[0][ks] = vtr(vp + v_rd_off(0, ks, 0)); vh[0][ks] = vtr(vp + v_rd_off(0, ks, 1)); }
      __builtin_amdgcn_sched_barrier(0);
#pragma unroll
      for (int d0 = 2; d0 < 4; ++d0) {
        s0 = __builtin_amdgcn_mfma_f32_32x32x16_bf16(ka[d0], qr[d0], s0, 0, 0, 0);
        s1 = __builtin_amdgcn_mfma_f32_32x32x16_bf16(kb[d0], qr[d0], s1, 0, 0, 0); }
      __builtin_amdgcn_sched_barrier(0);
#pragma unroll
      for (int ks = 0; ks < 4; ++ks) { vl[1][ks] = vtr(vp + v_rd_off(1, ks, 0)); vh[1][ks] = vtr(vp + v_rd_off(1, ks, 1)); }
      __builtin_amdgcn_sched_barrier(0);
#pragma unroll
      for (int d0 = 4; d0 < 6; ++d0) {
        s0 = __builtin_amdgcn_mfma_f32_32x32x16_bf16(ka[d0], qr[d0], s0, 0, 0, 0);
        s1 = __builtin_amdgcn_mfma_f32_32x32x16_bf16(kb[d0], qr[d0], s1, 0, 0, 0); }
#define PK(L, H) (bf16x8){L[0], L[1], L[2], L[3], H[0], H[1], H[2], H[3]}
      o[0] = __builtin_amdgcn_mfma_f32_32x32x16_bf16(pa0, PK(vl[0][0], vh[0][0]), o[0], 0, 0, 0);
      o[1] = __builtin_amdgcn_mfma_f32_32x32x16_bf16(pa0, PK(vl[1][0], vh[1][0]), o[1], 0, 0, 0);
      o[0] = __builtin_amdgcn_mfma_f32_32x32x16_bf16(pa1, PK(vl[0][1], vh[0][1]), o[0], 0, 0, 0);
      o[1] = __builtin_amdgcn_mfma_f32_32x32x16_bf16(pa1, PK(vl[1][1], vh[1][1]), o[1], 0, 0, 0);
      o[0] = __builtin_amdgcn_mfma_f32_32x32x16_bf16(pa2, PK(vl[0][2], vh[0][2]), o[0], 0, 0, 0);
      o[1] = __builtin_amdgcn_mfma_f32_32x32x16_bf16(pa2, PK(vl[1][2], vh[1][2]), o[1], 0, 0, 0);
      o[0] = __builtin_amdgcn_mfma_f32_32x32x16_bf16(pa3, PK(vl[0][3], vh[0][3]), o[0], 0, 0, 0);
      o[1] = __builtin_amdgcn_mfma_f32_32x32x16_bf16(pa3, PK(vl[1][3], vh[1][3]), o[1], 0, 0, 0);
      if (VAR == 8) __builtin_amdgcn_s_setprio(0);
    }
    if (g == 0) __syncthreads();
    {
      float pmax = s0[0];
      if (VAR != 3 && VAR != 11) {
#pragma unroll
      for (int r = 1; r < 16; ++r) pmax = fmaxf(pmax, s0[r]);
#pragma unroll
      for (int r = 0; r < 16; ++r) pmax = fmaxf(pmax, s1[r]); }
      { auto rr = __builtin_amdgcn_permlane32_swap(__float_as_uint(pmax), __float_as_uint(pmax), false, false);
        pmax = fmaxf(__uint_as_float(rr[0]), __uint_as_float(rr[1])); }
      float alpha = 1.f, ps = 0.f;
      if (__builtin_expect(j > 0 && __all(pmax <= THR2), 1)) {
#pragma unroll
        for (int r = 0; r < 16; ++r) { s0[r] = __builtin_amdgcn_exp2f(s0[r]); ps += s0[r]; }
#pragma unroll
        for (int r = 0; r < 16; ++r) { s1[r] = __builtin_amdgcn_exp2f(s1[r]); ps += s1[r]; }
      } else {
        const float dm = (j == 0) ? pmax : fmaxf(pmax, 0.f);
        alpha = (j == 0) ? 0.f : __builtin_amdgcn_exp2f(-dm);
        m_reg += dm;
#pragma unroll
        for (int r = 0; r < 16; ++r) { s0[r] = __builtin_amdgcn_exp2f(s0[r] - dm); ps += s0[r]; }
#pragma unroll
        for (int r = 0; r < 16; ++r) { s1[r] = __builtin_amdgcn_exp2f(s1[r] - dm); ps += s1[r]; }
#pragma unroll
        for (int r = 0; r < 16; ++r) negm[r] = -m_reg;
      }
      { auto rr = __builtin_amdgcn_permlane32_swap(__float_as_uint(ps), __float_as_uint(ps), false, false);
        ps = __uint_as_float(rr[0]) + __uint_as_float(rr[1]); }
      l_reg = l_reg * alpha + ps;
      if (__any(alpha < 1.f)) { if (hi == 0) al_l[r32] = alpha; asm volatile("s_waitcnt lgkmcnt(0)" ::: "memory");
#pragma unroll
        for (int d = 0; d < 2; ++d)
#pragma unroll
          for (int r = 0; r < 16; ++r) o[d][r] *= al_l[crow(r, hi)]; }
#define PK4(P, BASE, OUT) do { unsigned a0 = cvtpk(P[BASE + 0], P[BASE + 1]), a1 = cvtpk(P[BASE + 2], P[BASE + 3]);   \
    unsigned b0 = cvtpk(P[BASE + 4], P[BASE + 5]), b1 = cvtpk(P[BASE + 6], P[BASE + 7]);                              \
    auto r0 = __builtin_amdgcn_permlane32_swap(a0, b0, false, false); auto r1 = __builtin_amdgcn_permlane32_swap(a1, b1, false, false); \
    u32x4 w = {r0[0], r1[0], r0[1], r1[1]}; OUT = *reinterpret_cast<bf16x8*>(&w); } while (0)
      PK4(s0, 0, pa0); PK4(s0, 8, pa1); PK4(s1, 0, pa2); PK4(s1, 8, pa3);
#undef PK4
      const int nk = j + 2;
      if (VAR != 11) {
        const int wk = (rk == 0) ? 2 : rk - 1;
        const int wv = (rk == 2) ? 0 : rk + 1;
        if (nk - 1 < NT) WRITEV(wv);
        if (nk < NT) { WRITEK(wk); if (VAR != 1) LOADV(nk); }
        if (nk + 1 < NT && VAR != 1) LOADK(nk + 1);
      }
    }
    if (g == 1) __syncthreads();
    rv = rk; rk = (rk == 2) ? 0 : rk + 1;
  }
  {
    const LAS char* vp = vb + ((NT - 1) % 3) * SHM_V;
    s16x4 vl[2][4], vh[2][4];
#pragma unroll
    for (int d0 = 0; d0 < 2; ++d0)
#pragma unroll
      for (int ks = 0; ks < 4; ++ks) { vl[d0][ks] = vtr(vp + v_rd_off(d0, ks, 0)); vh[d0][ks] = vtr(vp + v_rd_off(d0, ks, 1)); }
    o[0] = __builtin_amdgcn_mfma_f32_32x32x16_bf16(pa0, PK(vl[0][0], vh[0][0]), o[0], 0, 0, 0);
    o[1] = __builtin_amdgcn_mfma_f32_32x32x16_bf16(pa0, PK(vl[1][0], vh[1][0]), o[1], 0, 0, 0);
    o[0] = __builtin_amdgcn_mfma_f32_32x32x16_bf16(pa1, PK(vl[0][1], vh[0][1]), o[0], 0, 0, 0);
    o[1] = __builtin_amdgcn_mfma_f32_32x32x16_bf16(pa1, PK(vl[1][1], vh[1][1]), o[1], 0, 0, 0);
    o[0] = __builtin_amdgcn_mfma_f32_32x32x16_bf16(pa2, PK(vl[0][2], vh[0][2]), o[0], 0, 0, 0);
    o[1] = __builtin_amdgcn_mfma_f32_32x32x16_bf16(pa2, PK(vl[1][2], vh[1][2]), o[1], 0, 0, 0);
    o[0] = __builtin_amdgcn_mfma_f32_32x32x16_bf16(pa3, PK(vl[0][3], vh[0][3]), o[0], 0, 0, 0);
    o[1] = __builtin_amdgcn_mfma_f32_32x32x16_bf16(pa3, PK(vl[1][3], vh[1][3]), o[1], 0, 0, 0);
#undef PK
  }
  if (g == 0) __syncthreads();
  if (hi == 0) li_l[r32] = l_reg; asm volatile("s_waitcnt lgkmcnt(0)" ::: "memory");
  float rli[16];
#pragma unroll
  for (int r = 0; r < 16; ++r) rli[r] = __builtin_amdgcn_rcpf(li_l[crow(r, hi)]);
  bf16* Ow = Ob + (size_t)(wid * QBLK) * ldo;
#pragma unroll
  for (int r = 0; r < 16; ++r) { const int orow = crow(r, hi);
#pragma unroll
    for (int d0 = 0; d0 < 2; ++d0) Ow[(size_t)orow * ldo + d0 * 32 + r32] = (bf16)(cvtpk(o[d0][r] * rli[r], 0.f) & 0xffffu); }
  __syncthreads();
#undef LOADK
#undef LOADV
#undef WRITEK
#undef WRITEV
}
}

constexpr int T_ = 32768, SEQ = 8192, NB = 4, NH = 8, DM = 1024, DFF = 2816, DEPTH = 2;
constexpr int NP = 1536;
constexpr float EPS = 1e-6f;
constexpr int O_Q = 0, O_KV = 384, O_KR = 640, O_POOL = 672, O_SGU = 928, O_SGV = 1184;
constexpr size_t MiB = 1u << 20;
constexpr size_t W_IN = 0, W_UQ = W_IN + (size_t)NP * 1024 * 2, W_UKV = W_UQ + (size_t)768 * 384 * 2, W_O = W_UKV + (size_t)1024 * 256 * 2,
                 W_GU = W_O + (size_t)1024 * 1024 * 2, W_DN = W_GU + (size_t)5632 * 1024 * 2, W_S = W_DN + (size_t)1024 * 2816 * 2, W_LAYER = 23 * MiB;
static_assert(W_S + 4 * 128 * 128 * 2 <= W_LAYER, "weight block");
constexpr size_t WS_W = 1 * MiB, WS_ROPE = 48 * MiB, WS_XA = 52 * MiB, WS_HB = 180 * MiB, WS_K = 52 * MiB  , WS_P = 244 * MiB, WS_Q = 244 * MiB,
                 WS_CQ = 340 * MiB, WS_CKV = 364 * MiB, WS_MIX = 380 * MiB, WS_V = 444 * MiB, WS_ACT = 244 * MiB, WS_END = 476 * MiB;
constexpr int LDS_BYTES = 131072 + 1024;
constexpr int N_PHASES = 16;
constexpr size_t WS_RSS = 65536;
constexpr size_t CTL_BYTES = 1 * MiB;

struct Args {
    const float* x; const int* pos; const float* mix_norm; const float* w_in; const float* q_norm; const float* kv_norm; const float* w_uq; const float* w_ukv;
    const float* w_pool; const float* pool_scale; const float* sg_norm; const float* w_s; const float* b_s; const float* w_o; const float* ffn_norm;
    const float* w_gate; const float* w_up; const float* w_down; const float* final_norm; float* out; unsigned char* ws; int ph_lo, ph_hi;
};

template <int MAP> __device__ __forceinline__ int map_row(int c, int extra) {
    if (MAP == 0) return c;
    if (MAP == 1) { const int h = c / 96, j = c - h * 96; if (j < 64) return c; const int i = j - 64; return h * 96 + 64 + 2 * (i & 15) + (i >> 4); }
    return (c >> 7) * 256 + extra * 128 + (c & 127);
}
template <int MAP>
__device__ __forceinline__ void transpose_item(const float* __restrict__ W, int K, int N, bf16* __restrict__ WT, LAS float* scr, int kb, int nb, int lane, int extra, const float* __restrict__ gk = nullptr) {
    const int k0 = 64 * kb, n0 = 32 * nb;
#pragma unroll 8
    for (int i = 0; i < 32; ++i) { const int kk = 2 * i + (lane >> 5); scr[kk * 33 + (lane & 31)] = W[(size_t)(k0 + kk) * N + n0 + (lane & 31)] * (gk ? gk[k0 + kk] : 1.f); }
    LDS_WAIT(); asm volatile("" ::: "memory");
    const int c = lane & 7;
#pragma unroll
    for (int j = 0; j < 4; ++j) { const int n = (lane >> 3) + 8 * j; const LAS float* s = scr + (8 * c) * 33 + n;
        u32x4 o; o.x = cvtpk(s[0 * 33], s[1 * 33]); o.y = cvtpk(s[2 * 33], s[3 * 33]); o.z = cvtpk(s[4 * 33], s[5 * 33]); o.w = cvtpk(s[6 * 33], s[7 * 33]);
        *(u32x4*)(WT + (size_t)map_row<MAP>(n0 + n, extra) * K + k0 + 8 * c) = o; }
    LDS_WAIT(); asm volatile("" ::: "memory");
}
__device__ __forceinline__ void prep_phase(const Args& a, LAS unsigned char* lds, const int tid, const int bx, const int G) {
    const int lane = tid & 63, wave = tid >> 6;
    LAS float* scr = (LAS float*)(lds + wave * 16384);
    const int gw = bx * 8 + wave, NGW = G * 8;
    constexpr int I0 = 16 * 45, I1 = 6 * 24, I2 = 4 * 32, I3 = 12 * 32, I4 = 16 * 88, I5 = I4, I6 = 44 * 32, IL = I0 + I1 + I2 + I3 + I4 + I5 + I6;
    for (int it = gw; it < DEPTH * IL; it += NGW) {
        const int l = it / IL; int r = it - l * IL; unsigned char* wl = a.ws + WS_W + (size_t)l * W_LAYER;
        if (r < I0) { transpose_item<0>(a.w_in + (size_t)l * 1024 * 1440, 1024, 1440, (bf16*)(wl + W_IN), scr, r / 45, r % 45, lane, 0, a.mix_norm + l * 1024); continue; } r -= I0;
        if (r < I1) { transpose_item<1>(a.w_uq + (size_t)l * 384 * 768, 384, 768, (bf16*)(wl + W_UQ), scr, r / 24, r % 24, lane, 0); continue; } r -= I1;
        if (r < I2) { transpose_item<0>(a.w_ukv + (size_t)l * 256 * 1024, 256, 1024, (bf16*)(wl + W_UKV), scr, r / 32, r % 32, lane, 0); continue; } r -= I2;
        if (r < I3) { int kb = r / 32; if (kb >= 8) kb += 4; transpose_item<0>(a.w_o + (size_t)l * 1024 * 1024, 1024, 1024, (bf16*)(wl + W_O), scr, kb, r % 32, lane, 0); continue; } r -= I3;
        if (r < I4) { transpose_item<2>(a.w_gate + (size_t)l * 1024 * 2816, 1024, 2816, (bf16*)(wl + W_GU), scr, r / 88, r % 88, lane, 0, a.ffn_norm + l * 1024); continue; } r -= I4;
        if (r < I5) { transpose_item<2>(a.w_up + (size_t)l * 1024 * 2816, 1024, 2816, (bf16*)(wl + W_GU), scr, r / 88, r % 88, lane, 1, a.ffn_norm + l * 1024); continue; } r -= I5;
        transpose_item<0>(a.w_down + (size_t)l * 2816 * 1024, 2816, 1024, (bf16*)(wl + W_DN), scr, r / 32, r % 32, lane, 0);
    }
    const int gt = bx * 512 + tid, NGT = G * 512;
    for (int i = gt; i < DEPTH * 12288; i += NGT) { const int l = i / 12288, c = i - l * 12288;
        *(u32x4*)(a.ws + WS_W + (size_t)l * W_LAYER + W_IN + (size_t)1440 * 1024 * 2 + (size_t)c * 16) = (u32x4){0u, 0u, 0u, 0u}; }
    for (int i = gt; i < DEPTH * 8192; i += NGT) { const int l = i / 8192, c = i - l * 8192; const float* s = a.w_s + (size_t)l * 65536 + (size_t)c * 8;
        const f32x4 v0 = *(const f32x4*)s, v1 = *(const f32x4*)(s + 4); u32x4 o; o.x = cvtpk(v0[0], v0[1]); o.y = cvtpk(v0[2], v0[3]); o.z = cvtpk(v1[0], v1[1]); o.w = cvtpk(v1[2], v1[3]);
        *(u32x4*)(a.ws + WS_W + (size_t)l * W_LAYER + W_S + (size_t)c * 16) = o; }
    for (int i = gt; i < DEPTH * 32768; i += NGT) { const int l = i >> 15, r = i & 32767, n = r & 1023, g = (r >> 10) & 3, cb = r >> 12;
        const float* wp = a.w_pool + ((size_t)(l * 4 + g) * 64 + cb * 8) * 64; const float* ps = a.pool_scale + l * 256 + g * 64; const float* wo = a.w_o + (size_t)l * 1024 * 1024 + (size_t)(512 + g * 64) * 1024 + n;
        float acc[8] = {0.f, 0.f, 0.f, 0.f, 0.f, 0.f, 0.f, 0.f};
        for (int d = 0; d < 64; ++d) { const float w = ps[d] * wo[(size_t)d * 1024];
#pragma unroll
            for (int e = 0; e < 8; ++e) acc[e] += wp[e * 64 + d] * w; }
        *(u32x4*)(a.ws + WS_W + (size_t)l * W_LAYER + W_O + ((size_t)n * 1024 + 512 + g * 64 + cb * 8) * 2) = pack8f(acc); }
    for (int i = gt; i < T_ * 16; i += NGT) { const int t = i >> 4, p = i & 15;
        const float inv = __builtin_amdgcn_exp2f(-(float)p * (13.287712379549449f / 16.f));
        const double rev = (double)a.pos[t] * (double)inv * 0.15915494309189535;
        const float fr = (float)(rev - __builtin_rint(rev));
        f32x2 cs; cs.x = __builtin_amdgcn_cosf(fr); cs.y = __builtin_amdgcn_sinf(fr);
        *(f32x2*)(a.ws + WS_ROPE + (size_t)i * 8) = cs; }
    for (int m = gw; m < T_; m += NGW) {
        const f32x4* xr = (const f32x4*)(a.x + (size_t)m * DM) + lane; u32x2* o = (u32x2*)((bf16*)(a.ws + WS_HB) + (size_t)m * DM) + lane;
        f32x4 v[4]; float ss = 0.f;
#pragma unroll
        for (int j = 0; j < 4; ++j) { v[j] = xr[64 * j]; ss += (v[j].x * v[j].x + v[j].y * v[j].y) + (v[j].z * v[j].z + v[j].w * v[j].w); }
#pragma unroll
        for (int j = 0; j < 4; ++j) { u32x2 w; w.x = cvtpk(v[j].x, v[j].y); w.y = cvtpk(v[j].z, v[j].w); o[64 * j] = w; }
        ss = wave_sum(ss, lane);
        if (lane == 0) ((float*)(a.ws + WS_RSS))[m] = ss;
    }
}

template <bool F32OUT>
__device__ __forceinline__ void norm_phase(const float* __restrict__ x, const float* __restrict__ g, void* outp, const int tid, const int bx, const int G) {
    const int lane = tid & 63, wave = tid >> 6, gw = bx * 8 + wave, NGW = G * 8;
    f32x4 gv[4];
#pragma unroll
    for (int j = 0; j < 4; ++j) gv[j] = *(const f32x4*)(g + 4 * lane + 256 * j);
    for (int m = gw; m < T_; m += NGW) {
        const f32x4* xr = (const f32x4*)(x + (size_t)m * DM) + lane;
        f32x4 v[4]; float s = 0.f;
#pragma unroll
        for (int j = 0; j < 4; ++j) { v[j] = xr[64 * j]; s += (v[j].x * v[j].x + v[j].y * v[j].y) + (v[j].z * v[j].z + v[j].w * v[j].w); }
        const float r = rsqrtf(wave_sum(s, lane) * (1.f / DM) + EPS);
        if (F32OUT) { f32x4* o = (f32x4*)((float*)outp + (size_t)m * DM) + lane;
#pragma unroll
            for (int j = 0; j < 4; ++j) o[64 * j] = v[j] * r * gv[j];
        } else { u32x2* o = (u32x2*)((bf16*)outp + (size_t)m * DM) + lane;
#pragma unroll
            for (int j = 0; j < 4; ++j) { const f32x4 y = v[j] * r * gv[j]; u32x2 w; w.x = cvtpk(y.x, y.y); w.y = cvtpk(y.z, y.w); o[64 * j] = w; } }
    }
}

constexpr int VT_ROW = 136;
__device__ __forceinline__ void mixprep_phase(const Args& a, int l, char* lds, const int tid, const int bx, const int G) {
    const int lane = tid & 63, wave = __builtin_amdgcn_readfirstlane(tid >> 6);
    const bf16* __restrict__ P = (const bf16*)(a.ws + WS_P); bf16* __restrict__ CQ = (bf16*)(a.ws + WS_CQ); bf16* __restrict__ CKV = (bf16*)(a.ws + WS_CKV); bf16* __restrict__ Kb = (bf16*)(a.ws + WS_K); bf16* __restrict__ MIX = (bf16*)(a.ws + WS_MIX);
    const float* __restrict__ rope = (const float*)(a.ws + WS_ROPE);
    const bf16* Wsb = (const bf16*)(a.ws + WS_W + (size_t)l * W_LAYER + W_S);
    const float* qn = a.q_norm + l * 384; const float* kvn = a.kv_norm + l * 256; const float* sgn = a.sg_norm + l * 256; const float* bs = a.b_s + l * 512;
    float g1[8], g2[8];
#pragma unroll
    for (int e = 0; e < 8; ++e) { g1[e] = lane < 48 ? qn[lane * 8 + e] : kvn[(lane - 48) * 8 + e]; g2[e] = lane < 16 ? kvn[128 + lane * 8 + e] : 0.f; }
    const int cch = tid & 31, gC = cch >> 3, d0C = (cch & 7) * 8;
    float g3[8];
#pragma unroll
    for (int e = 0; e < 8; ++e) g3[e] = sgn[gC * 64 + d0C + e];
    for (int chunk = bx; chunk < T_ / 128; chunk += G) {
        const int t0 = chunk * 128, b = chunk >> 6, s0 = (chunk & 63) * 128;
#pragma unroll 1
        for (int i0 = 0; i0 < 16; i0 += 4) {
          u32x4 c1b[4], c2b[4], rcb[4][2];
          const int pbase_l = (lane & 1) * 8 + ((lane & 2) ? 4 : 0);
#pragma unroll
          for (int u = 0; u < 4; ++u) { const bf16* prow = P + (size_t)(t0 + wave * 16 + i0 + u) * NP;
              c1b[u] = *(const u32x4*)(prow + lane * 8); c2b[u] = *(const u32x4*)(prow + 512 + lane * 8);
              const u32x4* cs = (const u32x4*)(rope + ((size_t)(t0 + wave * 16 + i0 + u) * 16 + pbase_l) * 2); rcb[u][0] = cs[0]; rcb[u][1] = cs[1]; }
#pragma unroll
          for (int u = 0; u < 4; ++u) {
            const int i = i0 + u;
            const int t = t0 + wave * 16 + i, s = s0 + wave * 16 + i;
            const u32x4 c1 = c1b[u]; u32x4 c2 = c2b[u]; if (lane >= 20) c2 = (u32x4){0u, 0u, 0u, 0u};
            float f1[8], f2[8]; unpack8(c1, f1); unpack8(c2, f2);
            float ss1 = 0.f, ss2 = 0.f;
#pragma unroll
            for (int e = 0; e < 8; ++e) { ss1 += f1[e] * f1[e]; ss2 += f2[e] * f2[e]; }
            const float sq = wave_sum(lane < 48 ? ss1 : 0.f, lane), skv = wave_sum((lane >= 48 ? ss1 : 0.f) + (lane < 16 ? ss2 : 0.f), lane);
            const float rq = rsqrtf(sq * (1.f / 384.f) + EPS), rkv = rsqrtf(skv * (1.f / 256.f) + EPS);
            float o1[8], o2[8]; const float r1 = lane < 48 ? rq : rkv;
#pragma unroll
            for (int e = 0; e < 8; ++e) { o1[e] = f1[e] * r1 * g1[e]; o2[e] = f2[e] * rkv * g2[e]; }
            if (lane < 48) *(u32x4*)(CQ + (size_t)t * 384 + lane * 8) = pack8f(o1);
            else *(u32x4*)(CKV + (size_t)t * 256 + (lane - 48) * 8) = pack8f(o1);
            if (lane < 16) *(u32x4*)(CKV + (size_t)t * 256 + 128 + lane * 8) = pack8f(o2);
            const f32x4 fa = {f2[0], f2[1], f2[2], f2[3]}, fb = {f2[4], f2[5], f2[6], f2[7]};
            f32x4 oa, ob;
#pragma unroll
            for (int e = 0; e < 4; ++e) { oa[e] = shx(fa[e], lane, 2); ob[e] = shx(fb[e], lane, 2); }
            if (lane >= 16 && lane < 20) {
                const bool up = (lane & 2) != 0;
                const int pbase = (lane & 1) * 8 + (up ? 4 : 0);
                const f32x4 mine = up ? fb : fa, oth = up ? ob : oa;
                const f32x4 t1 = up ? oth : mine, t2 = up ? mine : oth;
                const f32x4 c01 = __builtin_bit_cast(f32x4, rcb[u][0]), c23 = __builtin_bit_cast(f32x4, rcb[u][1]);
                f32x4 w0, w1;
                w0[0] = t1[0] * c01[0] - t2[0] * c01[1]; w0[1] = t1[0] * c01[1] + t2[0] * c01[0];
                w0[2] = t1[1] * c01[2] - t2[1] * c01[3]; w0[3] = t1[1] * c01[3] + t2[1] * c01[2];
                w1[0] = t1[2] * c23[0] - t2[2] * c23[1]; w1[1] = t1[2] * c23[1] + t2[2] * c23[0];
                w1[2] = t1[3] * c23[2] - t2[3] * c23[3]; w1[3] = t1[3] * c23[3] + t2[3] * c23[2];
                u32x4 pk; pk.x = cvtpk(w0[0], w0[1]); pk.y = cvtpk(w0[2], w0[3]); pk.z = cvtpk(w1[0], w1[1]); pk.w = cvtpk(w1[2], w1[3]);
#pragma unroll
                for (int h = 0; h < NH; ++h) *(u32x4*)(Kb + ((size_t)(b * NH + h) * SEQ + s) * 96 + 64 + 2 * pbase) = pk;
            }
          }
        }
        {
            const int g = wave >> 1, w = 2 << g, left = w >> 1, right = w - 1 - left;
            const int cch = g * 8 + (lane & 7), sf = s0 + (wave & 1) * 64 + (lane >> 3) * 8;
            const bf16* __restrict__ pc = P + (size_t)b * SEQ * NP + O_POOL + cch * 8;
            float acc[8] = {0.f, 0.f, 0.f, 0.f, 0.f, 0.f, 0.f, 0.f};
            for (int k = sf - left; k < sf + right; ++k) if (k >= 0 && k < SEQ) { float f[8]; unpack8(*(const u32x4*)(pc + (size_t)k * NP), f);
#pragma unroll
                for (int e = 0; e < 8; ++e) acc[e] += f[e]; }
            u32x4 ein[8], eout[8], eself[8];
#pragma unroll
            for (int i = 0; i < 8; ++i) { const int kin = sf + i + right, kout = sf + i - left;
                ein[i] = (kin < SEQ) ? *(const u32x4*)(pc + (size_t)kin * NP) : (u32x4){0u, 0u, 0u, 0u};
                eout[i] = (kout >= 0) ? *(const u32x4*)(pc + (size_t)kout * NP) : (u32x4){0u, 0u, 0u, 0u};
                eself[i] = *(const u32x4*)(pc + (size_t)(sf + i) * NP); }
#pragma unroll
            for (int i = 0; i < 8; ++i) {
                const int s = sf + i; const int lo = s - left < 0 ? 0 : s - left, hi = s + right + 1 > SEQ ? SEQ : s + right + 1;
                float fi[8], fo[8], fs[8], d[8]; unpack8(ein[i], fi); unpack8(eout[i], fo); unpack8(eself[i], fs);
                const float inv = 1.f / (float)(hi - lo);
#pragma unroll
                for (int e = 0; e < 8; ++e) { acc[e] += fi[e]; d[e] = acc[e] * inv - fs[e]; acc[e] -= fo[e]; }
                *(u32x4*)(MIX + (size_t)(b * SEQ + s) * DM + 512 + cch * 8) = pack8f(d);
            }
        }
        bf16* vT = (bf16*)lds;
        u32x4 zb[8];
#pragma unroll
        for (int it = 0; it < 8; ++it) zb[it] = *(const u32x4*)(P + (size_t)(t0 + it * 16 + (tid >> 5)) * NP + O_SGV + gC * 64 + d0C);
#pragma unroll
        for (int it = 0; it < 8; ++it) {
            const int tok = it * 16 + (tid >> 5);
            float z[8]; unpack8(zb[it], z);
            float ss = 0.f;
#pragma unroll
            for (int e = 0; e < 8; ++e) { z[e] = gelu_tanh(z[e]); ss += z[e] * z[e]; }
            ss += shx(ss, lane, 1); ss += shx(ss, lane, 2); ss += shx(ss, lane, 4);
            const float r = rsqrtf(ss * (1.f / 64.f) + EPS);
#pragma unroll
            for (int e = 0; e < 8; ++e) vT[(size_t)(gC * 64 + d0C + e) * VT_ROW + tok] = (bf16)(cvtpk(z[e] * r * g3[e], 0.f) & 0xffffu);
        }
        __syncthreads();
        {
            const int g = wave >> 1, ph = (wave & 1) * 64, fr = lane & 15, fq = lane >> 4;
            f32x4 acc[4][4];
#pragma unroll
            for (int m = 0; m < 4; ++m)
#pragma unroll
                for (int n = 0; n < 4; ++n) acc[m][n] = (f32x4){0.f, 0.f, 0.f, 0.f};
#pragma unroll
            for (int kk = 0; kk < 4; ++kk) {
                bf16x8 va[4], wb[4];
#pragma unroll
                for (int m = 0; m < 4; ++m) va[m] = *(const bf16x8*)(vT + (size_t)(g * 64 + m * 16 + fr) * VT_ROW + kk * 32 + fq * 8);
#pragma unroll
                for (int n = 0; n < 4; ++n) wb[n] = *(const bf16x8*)(Wsb + ((size_t)(g * 128 + ph + n * 16 + fr)) * 128 + kk * 32 + fq * 8);
#pragma unroll
                for (int m = 0; m < 4; ++m)
#pragma unroll
                    for (int n = 0; n < 4; ++n) acc[m][n] = __builtin_amdgcn_mfma_f32_16x16x32_bf16(va[m], wb[n], acc[m][n], 0, 0, 0);
            }
#pragma unroll
            for (int n = 0; n < 4; ++n) { const int p = ph + n * 16 + fr; const float bias = bs[g * 128 + p]; const size_t t = (size_t)(t0 + p);
#pragma unroll
                for (int m = 0; m < 4; ++m) { const int d = 16 * m + 4 * fq;
                    const u32x2 uu = *(const u32x2*)(P + t * NP + O_SGU + g * 64 + d);
                    const float u0 = gelu_tanh(bflo(uu.x)), u1 = gelu_tanh(bfhi(uu.x)), u2 = gelu_tanh(bflo(uu.y)), u3 = gelu_tanh(bfhi(uu.y));
                    u32x2 o; o.x = cvtpk(u0 * (acc[m][n][0] + bias), u1 * (acc[m][n][1] + bias)); o.y = cvtpk(u2 * (acc[m][n][2] + bias), u3 * (acc[m][n][3] + bias));
                    *(u32x2*)(MIX + t * DM + 768 + g * 64 + d) = o; } }
        }
        __syncthreads();
    }
}

template <int VAR> __device__ __forceinline__ void attn_phase(const Args& a, char* lds, const int tid, const int bx, const int G) {
    const bf16* Q = (const bf16*)(a.ws + WS_Q); const bf16* Kb = (const bf16*)(a.ws + WS_K); const bf16* Vb = (const bf16*)(a.ws + WS_V); bf16* MIX = (bf16*)(a.ws + WS_MIX);
    for (int i = 0;; ++i) {
        int bh, qb;
        if ((G & 7) == 0) { const int sl = i * (G >> 3) + (bx >> 3); if (sl >= 128) break; bh = (sl >> 5) * 8 + (bx & 7); qb = sl & 31; }
        else { const int u = i * G + bx; if (u >= 1024) break; bh = u >> 5; qb = u & 31; }
        const int b = bh >> 3, h = bh & 7;
        att::attn_unit<VAR>(Q + ((size_t)bh * SEQ + qb * 256) * 96, Kb + (size_t)bh * SEQ * 96, Vb + (size_t)bh * SEQ * 64, MIX + ((size_t)(b * SEQ + qb * 256)) * DM + h * 64, DM, lds, tid, (qb * 4) & 127);
    }
}

#ifndef EN_MASK
#define EN_MASK 0xffff
#endif
#define EN(i) (((EN_MASK) >> (i)) & 1)
template <class Epi> __device__ __forceinline__ void run_gemm(LAS unsigned char* ldsl, const void* A, const void* Bt, int N, int K, const Epi& E, int tid, int bx, int G) {
    asm volatile("" : "+v"(tid));
    pg8::Gemm g{(const pg8::bf16_t*)A, (const pg8::bf16_t*)Bt, T_, N, K}; pg8::StaticOrder S; S.init(T_, N, G, bx);
    pg8::gemm_phase<Epi, pg8::StaticOrder, true, true>(ldsl, g, S, E, tid);
}
#define AS4 __attribute__((address_space(4)))
#ifndef DBL_MASK
#define DBL_MASK 0
#endif
constexpr int dbl_bit(int ph) { return (ph == 0) ? 0 : (ph == N_PHASES - 1) ? 15 : ((ph - 1) % 7 == 0) ? 2 : ((ph - 1) % 7 == 1) ? 3 : ((ph - 1) % 7 == 2) ? 4 : ((ph - 1) % 7 == 3) ? 6 : ((ph - 1) % 7 == 5) ? 8 : 15; }
#ifndef BAR_REPS
#define BAR_REPS 1
#endif
#ifndef ATT_VAR
#define ATT_VAR 0
#endif
#define DBLP(PH) (((DBL_MASK) >> dbl_bit(PH)) & 1)
template <int PH, int VAR> __device__ __forceinline__ void run_phase(LAS unsigned char* ldsl, unsigned char* lds_raw, const int wave_s) {
    int zv = 0; asm volatile("" : "+v"(zv));
    int tid = wave_s * 64 + (int)__builtin_amdgcn_mbcnt_hi(~0u, __builtin_amdgcn_mbcnt_lo(~0u, (unsigned)zv)); asm volatile("" : "+v"(tid));
    int bx = blockIdx.x, G = gridDim.x, koff = 0; asm volatile("" : "+s"(bx), "+s"(G), "+s"(koff));
#if defined(__HIP_DEVICE_COMPILE__)
    const Args a = *(const AS4 Args*)((const AS4 char*)__builtin_amdgcn_kernarg_segment_ptr() + koff);
#else
    const Args a{};
#endif
    if (PH == 0) { if (EN(0)) prep_phase(a, ldsl, tid, bx, G); }
    else if (PH == N_PHASES - 1) { if (EN(1)) norm_phase<true>(a.out, a.final_norm, a.out, tid, bx, G); }
    else {
        constexpr int l = (PH - 1) / 7, k = (PH - 1) % 7;
        unsigned char* wl = a.ws + WS_W + (size_t)l * W_LAYER;
        float* rss0 = (float*)(a.ws + WS_RSS) + (size_t)(l * 2) * T_; float* rss1 = rss0 + T_;
        if (k == 0) { if (EN(2)) { pg8::EpiStore E{(pg8::bf16_t*)(a.ws + WS_P), NP, rss0}; run_gemm(ldsl, a.ws + WS_HB, wl + W_IN, NP, DM, E, tid, bx, G); } }
        else if (k == 1) { if (EN(3)) mixprep_phase(a, l, (char*)lds_raw, tid, bx, G); }
        else if (k == 2) {
            if (EN(4)) { pg8::EpiQ E{(pg8::bf16_t*)(a.ws + WS_Q), (const float*)(a.ws + WS_ROPE), 0.10206207261596575f * 1.4426950408889634f}; run_gemm(ldsl, a.ws + WS_CQ, wl + W_UQ, 768, 384, E, tid, bx, G); }
            if (EN(5)) { asm volatile("" : "+v"(tid)); pg8::EpiKV E{(pg8::bf16_t*)(a.ws + WS_K), (pg8::bf16_t*)(a.ws + WS_V)}; run_gemm(ldsl, a.ws + WS_CKV, wl + W_UKV, 1024, 256, E, tid, bx, G); }
        }
        else if (k == 3) { if (EN(6)) attn_phase<VAR>(a, (char*)lds_raw, tid, bx, G); }
        else if (k == 4) { if (EN(7)) {
            if (l == 0) { pg8::EpiRes<false, false, true> E{a.x, nullptr, DM, (pg8::bf16_t*)(a.ws + WS_HB), rss1}; run_gemm(ldsl, a.ws + WS_MIX, wl + W_O, DM, DM, E, tid, bx, G); }
            else { pg8::EpiRes<true, false, true> E{nullptr, nullptr, DM, (pg8::bf16_t*)(a.ws + WS_HB), rss1}; run_gemm(ldsl, a.ws + WS_MIX, wl + W_O, DM, DM, E, tid, bx, G); } } }
        else if (k == 5) { if (EN(8)) { pg8::EpiGU E{(pg8::bf16_t*)(a.ws + WS_ACT), DFF, rss1}; run_gemm(ldsl, a.ws + WS_HB, wl + W_GU, 2 * DFF, DM, E, tid, bx, G); } }
        else { if (EN(7)) {
            if (l + 1 < DEPTH) { pg8::EpiRes<true, false, true> E{nullptr, nullptr, DM, (pg8::bf16_t*)(a.ws + WS_HB), rss1 + T_}; run_gemm(ldsl, a.ws + WS_ACT, wl + W_DN, DM, DFF, E, tid, bx, G); }
            else { pg8::EpiRes<true, true, false> E{nullptr, a.out, DM, (pg8::bf16_t*)(a.ws + WS_HB), nullptr}; run_gemm(ldsl, a.ws + WS_ACT, wl + W_DN, DM, DFF, E, tid, bx, G); } } }
    }
}
#define XB_TMO      128
#define XB_XCNT(j)  (256  + 64 * (j))
#define XB_XSUB(j)  (1280 + 64 * (j))
#define XB_XGEN(j)  (2304 + 64 * (j))
#define XB_TOP      3328
#define XB_TOPGEN   3392
#define XB_SPIN_CAP (1u << 22)
__device__ __forceinline__ unsigned xb_ld(unsigned* p)              { return __hip_atomic_load(p, __ATOMIC_RELAXED, __HIP_MEMORY_SCOPE_AGENT); }
__device__ __forceinline__ unsigned xb_add(unsigned* p, unsigned v) { return __hip_atomic_fetch_add(p, v, __ATOMIC_RELAXED, __HIP_MEMORY_SCOPE_AGENT); }
__device__ __forceinline__ unsigned xb_xcc_id() { return (unsigned)__builtin_amdgcn_s_getreg((3 << 11) | 20) & 0xFu; }
#define XB_SPIN(cond, bar) do { unsigned _sp = 0; while (cond) { __builtin_amdgcn_s_sleep(1); \
    if ((++_sp & 255u) == 0u) { if (xb_ld(&(bar)[XB_TMO])) break; if (_sp > XB_SPIN_CAP) { atomicAdd(&(bar)[XB_TMO], 1u); break; } } } } while (0)
__device__ __forceinline__ bool is_thread0(const int wave_s) {
    if (wave_s != 0) return false;
    int zv = 0; asm volatile("" : "+v"(zv));
    return __builtin_amdgcn_mbcnt_hi(~0u, __builtin_amdgcn_mbcnt_lo(~0u, (unsigned)zv)) == 0;
}
__device__ __forceinline__ void xcd_barrier_complete(unsigned* bar, unsigned x, unsigned G, unsigned& nloc, unsigned& nx) {
    unsigned sum, cnt, mine, sp = 0u;
    for (;;) {
        sum = 0u; cnt = 0u; mine = 0u;
#pragma unroll
        for (unsigned j = 0; j < 16; ++j) { const unsigned c = xb_ld(&bar[XB_XCNT(j)]); sum += c; cnt += (c > 0u) ? 1u : 0u; mine = (j == x) ? c : mine; }
        if (sum == G) break;
        __builtin_amdgcn_s_sleep(1);
        if ((++sp & 255u) == 0u) { if (xb_ld(&bar[XB_TMO])) break; if (sp > XB_SPIN_CAP) { atomicAdd(&bar[XB_TMO], 1u); break; } }
    }
    nloc = mine > 0u ? mine : 1u; nx = cnt > 0u ? cnt : 1u;
}
__device__ __forceinline__ void grid_barrier(unsigned* bar, const int wave_s, const unsigned x, volatile LAS unsigned* st, const unsigned G) {
    asm volatile("s_waitcnt vmcnt(0)" ::: "memory");
    __syncthreads();
    if (is_thread0(wave_s)) {
        __builtin_amdgcn_s_waitcnt(0);
        unsigned nloc = st[0], nx = st[1];
        if (nloc == 0u) { xcd_barrier_complete(bar, x, G, nloc, nx); st[0] = nloc; st[1] = nx; }
        const unsigned old = xb_add(&bar[XB_XSUB(x)], 1u);
        const unsigned gen = old / nloc;
        if (old + 1u == (gen + 1u) * nloc) {
            __builtin_amdgcn_fence(__ATOMIC_RELEASE, "agent");
            asm volatile("s_waitcnt vmcnt(0)" ::: "memory");
            const unsigned og = xb_add(&bar[XB_TOP], 1u);
            const unsigned tg = og / nx;
            if (og + 1u == (tg + 1u) * nx) xb_add(&bar[XB_TOPGEN], 1u);
            else XB_SPIN(xb_ld(&bar[XB_TOPGEN]) == tg, bar);
            __builtin_amdgcn_fence(__ATOMIC_ACQUIRE, "agent");
            xb_add(&bar[XB_XGEN(x)], 1u);
            asm volatile("s_waitcnt vmcnt(0)" ::: "memory");
        } else {
            XB_SPIN(xb_ld(&bar[XB_XGEN(x)]) == gen, bar);
            __builtin_amdgcn_fence(__ATOMIC_ACQUIRE, "agent");
            asm volatile("s_waitcnt vmcnt(0)" ::: "memory");
        }
    }
    __syncthreads();
}
__global__ void __launch_bounds__(512, 2) fwd(Args ka) {
    extern __shared__ __attribute__((aligned(16))) unsigned char lds_raw[];
    const int lo = ka.ph_lo, hi = ka.ph_hi;
    if (lo < 0) cg::this_grid().sync();
    LAS unsigned char* ldsl = (LAS unsigned char*)lds_raw;
    const int wave_s = __builtin_amdgcn_readfirstlane((int)(threadIdx.x >> 6));
    unsigned* bar = (unsigned*)ka.ws + 4096;
    const unsigned G0 = gridDim.x;
    volatile LAS unsigned* st = (volatile LAS unsigned*)(ldsl + 131072 + 64);
    const unsigned xcc = xb_xcc_id();
    if (is_thread0(wave_s)) { st[0] = 0u; st[1] = 0u; (void)xb_add(&bar[XB_XCNT(xcc)], 1u); }
    __syncthreads();
#define STEP(PH) if (lo <= (PH) && (PH) < hi) { if (DBLP(PH)) { run_phase<PH, ATT_VAR>(ldsl, lds_raw, wave_s); __syncthreads(); } run_phase<PH, 0>(ldsl, lds_raw, wave_s); if ((PH) + 1 < hi) { for (int rep_ = 0; rep_ < BAR_REPS; ++rep_) grid_barrier(bar, wave_s, xcc, st, G0); } }
    STEP(0) STEP(1) STEP(2) STEP(3) STEP(4) STEP(5) STEP(6) STEP(7) STEP(8) STEP(9)
    STEP(10) STEP(11) STEP(12) STEP(13) STEP(14) STEP(15)
#undef STEP
}

extern "C" void kernel_launch(void* const* d_in, const int* in_sizes, int n_in, void* d_out, int out_size, void* d_ws, size_t ws_size, hipStream_t stream) {
    static int grid = 0;
    if (grid == 0) {
        if (n_in != 19 || in_sizes[0] != T_ * DM || out_size != T_ * DM || ws_size < WS_END) {
            fprintf(stderr, "kernel_launch: shape mismatch n_in %d in0 %d out %d ws %zu (need %zu)\n", n_in, n_in > 0 ? in_sizes[0] : -1, out_size, ws_size, (size_t)WS_END); grid = -1; return; }
        int dev = 0, cus = 0, per_cu = 0;
        if (hipGetDevice(&dev) != hipSuccess || hipDeviceGetAttribute(&cus, hipDeviceAttributeMultiprocessorCount, dev) != hipSuccess) { grid = -1; return; }
        if (hipFuncSetAttribute((const void*)fwd, hipFuncAttributeMaxDynamicSharedMemorySize, LDS_BYTES) != hipSuccess) { fprintf(stderr, "kernel_launch: hipFuncSetAttribute failed\n"); grid = -1; return; }
        if (hipOccupancyMaxActiveBlocksPerMultiprocessor(&per_cu, (const void*)fwd, 512, LDS_BYTES) != hipSuccess || per_cu < 1) { fprintf(stderr, "kernel_launch: occupancy query says %d\n", per_cu); per_cu = 1; }
        (void)hipGetLastError();
        grid = cus;
    }
    if (grid < 0) return;
    Args a{};
    a.x = (const float*)d_in[0]; a.pos = (const int*)d_in[1]; a.mix_norm = (const float*)d_in[2]; a.w_in = (const float*)d_in[3]; a.q_norm = (const float*)d_in[4];
    a.kv_norm = (const float*)d_in[5]; a.w_uq = (const float*)d_in[6]; a.w_ukv = (const float*)d_in[7]; a.w_pool = (const float*)d_in[8]; a.pool_scale = (const float*)d_in[9];
    a.sg_norm = (const float*)d_in[10]; a.w_s = (const float*)d_in[11]; a.b_s = (const float*)d_in[12]; a.w_o = (const float*)d_in[13]; a.ffn_norm = (const float*)d_in[14];
    a.w_gate = (const float*)d_in[15]; a.w_up = (const float*)d_in[16]; a.w_down = (const float*)d_in[17]; a.final_norm = (const float*)d_in[18];
    a.out = (float*)d_out; a.ws = (unsigned char*)d_ws;
    if (hipMemsetAsync(d_ws, 0, CTL_BYTES, stream) != hipSuccess) { fprintf(stderr, "kernel_launch: memset failed\n"); return; }
#if MK_MULTI
    for (int ph = 0; ph < N_PHASES; ++ph) { a.ph_lo = ph; a.ph_hi = ph + 1; void* args[] = {&a};
        hipError_t e = hipLaunchCooperativeKernel((const void*)fwd, dim3(grid), dim3(512), args, LDS_BYTES, stream);
        if (e != hipSuccess) { fprintf(stderr, "kernel_launch: launch ph %d failed: %s\n", ph, hipGetErrorString(e)); return; } }
#else
    a.ph_lo = 0; a.ph_hi = N_PHASES; void* args[] = {&a};
    hipError_t e = hipLaunchCooperativeKernel((const void*)fwd, dim3(grid), dim3(512), args, LDS_BYTES, stream);
    if (e != hipSuccess) fprintf(stderr, "kernel_launch: cooperative launch failed: %s (grid %d)\n", hipGetErrorString(e), grid);
#endif
}
```

```cpp
#include <hip/hip_runtime.h>
#include <hip/hip_cooperative_groups.h>
#include <cstdio>
#include <cstdint>
namespace cg = cooperative_groups;

#ifndef MK_MULTI
#define MK_MULTI 0
#endif

namespace pg8 {
#define PG8_LAS __attribute__((address_space(3)))
typedef unsigned short bf16_t;
typedef short bf16x8 __attribute__((ext_vector_type(8)));
typedef float f32x4 __attribute__((ext_vector_type(4)));
typedef unsigned u32x4 __attribute__((ext_vector_type(4)));
constexpr int BM = 256, BK = 64, HALF = 128, HTB = HALF * BK * 2  , STAGE_BYTES = 8 * HTB, NXCD = 8, WGM = 8;

__host__ __device__ __forceinline__ int lds_byte(int r, int c) { const int st = (r >> 4) * 2 + (c >> 5), rr = r & 15, cc = c & 31, ob = rr * 64 + cc * 2; return st * 1024 + (ob ^ (((ob >> 9) & 1) << 5)); }
__host__ __device__ __forceinline__ void stage_rc(int b, int& R, int& C) { const int st = b / 1024, sb = b % 1024, swz = sb ^ (((sb >> 9) & 1) << 5); R = (st >> 1) * 16 + swz / 64; C = (st & 1) * 32 + (swz % 64) / 2; }
__host__ __device__ __forceinline__ int perm32(int rho) { const int n = rho >> 4, i = rho & 15; return 8 * (i >> 2) + 4 * n + (i & 3); }

struct Unit { int pm, pn; };
struct Gemm { const bf16_t* A; const bf16_t* Bt; int M, N, K; };

struct StaticOrder {
    int nM, nN, nwg, G, c;
    __host__ __device__ void init(int M, int N, int G_, int c_) { nM = M / BM; nN = N / BM; nwg = nM * nN; G = G_; c = c_; }
    __host__ __device__ bool next(int i, Unit& u) const {
        const long L = (long)i * G + c; if (L >= nwg) return false;
        int wgid = (int)L; { const int q = nwg / NXCD, r = nwg % NXCD, xcd = wgid % NXCD, off = wgid / NXCD; wgid = (xcd < r ? xcd * (q + 1) : r * (q + 1) + (xcd - r) * q) + off; }
        const int nig = WGM * nN, gid = wgid / nig, fm = gid * WGM, gsz = (nM - fm) < WGM ? (nM - fm) : WGM;
        u.pm = fm + ((wgid % nig) % gsz); u.pn = (wgid % nig) / gsz; return true;
    }
    __device__ __forceinline__ void a_ready(const Unit&) const {}
    __device__ __forceinline__ void done(const Unit&) const {}
};

__device__ __forceinline__ unsigned cvt_pk_bf16(float lo, float hi) { unsigned r; asm volatile("v_cvt_pk_bf16_f32 %0, %1, %2" : "=v"(r) : "v"(lo), "v"(hi)); return r; }
__device__ __forceinline__ u32x4 pack8(const f32x4 v0, const f32x4 v1) { u32x4 w; w.x = cvt_pk_bf16(v0[0], v0[1]); w.y = cvt_pk_bf16(v0[2], v0[3]); w.z = cvt_pk_bf16(v1[0], v1[1]); w.w = cvt_pk_bf16(v1[2], v1[3]); return w; }
constexpr int SEQ_ = 8192, NH_ = 8;

struct EpiStore {
    static constexpr bool PERM = true, AFTER_DRAIN = false;
    bf16_t* O; int ldc; const float* rss;
    __device__ __forceinline__ void operator()(const f32x4 (&acc)[2][2][4][2], const Unit& u, int wr, int wc, int fr_, int fq_) const {
        int fr = fr_, fq = fq_; asm volatile("" : "+v"(fr), "+v"(fq));
        const int row0 = u.pm * BM + wr * 64 + fr, col0 = u.pn * BM + wc * 32 + 8 * fq;
#pragma unroll
        for (int ai = 0; ai < 2; ++ai)
#pragma unroll
            for (int m = 0; m < 4; ++m) { const int row = row0 + ai * HALF + m * 16; bf16_t* rowp = O + (size_t)row * ldc + col0;
                const float sc = __builtin_amdgcn_rsqf(rss[row] * (1.f / 1024.f) + 1e-6f);
#pragma unroll
                for (int bj = 0; bj < 2; ++bj) *(u32x4*)(rowp + bj * HALF) = pack8(acc[ai][bj][m][0] * sc, acc[ai][bj][m][1] * sc); asm volatile("" ::: "memory"); }
    }
};
struct EpiQ {
    static constexpr bool PERM = true, AFTER_DRAIN = false;
    bf16_t* Q; const float* rope; float c2;
    __device__ __forceinline__ void operator()(const f32x4 (&acc)[2][2][4][2], const Unit& u, int wr, int wc, int fr_, int fq_) const {
        int fr = fr_, fq = fq_; asm volatile("" : "+v"(fr), "+v"(fq));
        const int row0 = u.pm * BM + wr * 64 + fr;
#pragma unroll
        for (int bj = 0; bj < 2; ++bj) {
            const int col = u.pn * BM + bj * HALF + wc * 32 + 8 * fq; const int h = col / 96, j = col - h * 96;
#pragma unroll
            for (int ai = 0; ai < 2; ++ai)
#pragma unroll
                for (int m = 0; m < 4; ++m) {
                    const int row = row0 + ai * HALF + m * 16; const int b = row >> 13, s = row & (SEQ_ - 1);
                    f32x4 v0 = acc[ai][bj][m][0], v1 = acc[ai][bj][m][1];
                    if (j >= 64) {
                        const f32x4* cs = (const f32x4*)(rope + ((size_t)row * 16 + ((j - 64) >> 1)) * 2);
                        const f32x4 c01 = cs[0], c23 = cs[1];
                        f32x4 w0, w1;
                        w0[0] = v0[0] * c01[0] - v0[1] * c01[1]; w0[1] = v0[0] * c01[1] + v0[1] * c01[0];
                        w0[2] = v0[2] * c01[2] - v0[3] * c01[3]; w0[3] = v0[2] * c01[3] + v0[3] * c01[2];
                        w1[0] = v1[0] * c23[0] - v1[1] * c23[1]; w1[1] = v1[0] * c23[1] + v1[1] * c23[0];
                        w1[2] = v1[2] * c23[2] - v1[3] * c23[3]; w1[3] = v1[2] * c23[3] + v1[3] * c23[2];
                        v0 = w0; v1 = w1;
                    }
                    v0 = v0 * c2; v1 = v1 * c2;
                    *(u32x4*)(Q + ((size_t)(b * NH_ + h) * SEQ_ + s) * 96 + j) = pack8(v0, v1); asm volatile("" ::: "memory");
                }
        }
    }
};
struct EpiKV {
    static constexpr bool PERM = true, AFTER_DRAIN = false;
    bf16_t* Kb; bf16_t* Vb;
    __device__ __forceinline__ void operator()(const f32x4 (&acc)[2][2][4][2], const Unit& u, int wr, int wc, int fr_, int fq_) const {
        int fr = fr_, fq = fq_; asm volatile("" : "+v"(fr), "+v"(fq));
        const int row0 = u.pm * BM + wr * 64 + fr;
#pragma unroll
        for (int bj = 0; bj < 2; ++bj) {
            const int col = u.pn * BM + bj * HALF + wc * 32 + 8 * fq; const int h = col >> 7, j = col & 127;
#pragma unroll
            for (int ai = 0; ai < 2; ++ai)
#pragma unroll
                for (int m = 0; m < 4; ++m) {
                    const int row = row0 + ai * HALF + m * 16; const int b = row >> 13, s = row & (SEQ_ - 1);
                    const size_t tok = (size_t)(b * NH_ + h) * SEQ_ + s;
                    bf16_t* dst = (j < 64) ? (Kb + tok * 96 + j) : (Vb + tok * 64 + (j - 64));
                    *(u32x4*)dst = pack8(acc[ai][bj][m][0], acc[ai][bj][m][1]); asm volatile("" ::: "memory");
                }
        }
    }
};
template <bool RESB, bool OUTF, bool STATS> struct EpiRes {
    static constexpr bool PERM = true, AFTER_DRAIN = false;
    const float* res; float* out; int ldc; bf16_t* xb; float* rss;
    __device__ __forceinline__ void operator()(const f32x4 (&acc)[2][2][4][2], const Unit& u, int wr, int wc, int fr_, int fq_) const {
        int fr = fr_, fq = fq_; asm volatile("" : "+v"(fr), "+v"(fq));
        const int row0 = u.pm * BM + wr * 64 + fr, col0 = u.pn * BM + wc * 32 + 8 * fq, lane = fq * 16 + fr;
#pragma unroll
        for (int ai = 0; ai < 2; ++ai)
#pragma unroll
            for (int m = 0; m < 4; ++m) { const int row = row0 + ai * HALF + m * 16; const size_t off = (size_t)row * ldc + col0; float ss = 0.f;
#pragma unroll
                for (int bj = 0; bj < 2; ++bj) {
                    f32x4 r0, r1;
                    if (RESB) { const u32x4 w = *(const u32x4*)(xb + off + bj * HALF);
                        r0[0] = __builtin_bit_cast(float, w.x << 16); r0[1] = __builtin_bit_cast(float, w.x & 0xffff0000u); r0[2] = __builtin_bit_cast(float, w.y << 16); r0[3] = __builtin_bit_cast(float, w.y & 0xffff0000u);
                        r1[0] = __builtin_bit_cast(float, w.z << 16); r1[1] = __builtin_bit_cast(float, w.z & 0xffff0000u); r1[2] = __builtin_bit_cast(float, w.w << 16); r1[3] = __builtin_bit_cast(float, w.w & 0xffff0000u); }
                    else { r0 = *(const f32x4*)(res + off + bj * HALF); r1 = *(const f32x4*)(res + off + bj * HALF + 4); }
                    const f32x4 y0 = r0 + acc[ai][bj][m][0], y1 = r1 + acc[ai][bj][m][1];
                    if (OUTF) { *(f32x4*)(out + off + bj * HALF) = y0; *(f32x4*)(out + off + bj * HALF + 4) = y1; }
                    else *(u32x4*)(xb + off + bj * HALF) = pack8(y0, y1);
                    if (STATS) ss += (y0[0] * y0[0] + y0[1] * y0[1]) + (y0[2] * y0[2] + y0[3] * y0[3]) + (y1[0] * y1[0] + y1[1] * y1[1]) + (y1[2] * y1[2] + y1[3] * y1[3]); }
                if (STATS) {
                    ss += __builtin_bit_cast(float, __builtin_amdgcn_ds_bpermute((lane ^ 16) << 2, __builtin_bit_cast(int, ss)));
                    ss += __builtin_bit_cast(float, __builtin_amdgcn_ds_bpermute((lane ^ 32) << 2, __builtin_bit_cast(int, ss)));
                    if (fq == 0) atomicAdd(rss + row, ss);
                }
                asm volatile("" ::: "memory"); }
    }
};
struct EpiFinal {
    static constexpr bool PERM = true, AFTER_DRAIN = false;
    const bf16_t* xb; float* out; int ldc; float* rss; unsigned* cnt; const float* g; int ntn;
    __device__ __forceinline__ void operator()(const f32x4 (&acc)[2][2][4][2], const Unit& u, int wr, int wc, int fr_, int fq_) const {
        int fr = fr_, fq = fq_; asm volatile("" : "+v"(fr), "+v"(fq));
        const int row0 = u.pm * BM + wr * 64 + fr, col0 = u.pn * BM + wc * 32 + 8 * fq, lane = fq * 16 + fr;
#pragma unroll
        for (int ai = 0; ai < 2; ++ai)
#pragma unroll
            for (int m = 0; m < 4; ++m) { const int row = row0 + ai * HALF + m * 16; const size_t off = (size_t)row * ldc + col0; float ss = 0.f;
#pragma unroll
                for (int bj = 0; bj < 2; ++bj) { const u32x4 w = *(const u32x4*)(xb + off + bj * HALF);
                    f32x4 r0, r1;
                    r0[0] = __builtin_bit_cast(float, w.x << 16); r0[1] = __builtin_bit_cast(float, w.x & 0xffff0000u); r0[2] = __builtin_bit_cast(float, w.y << 16); r0[3] = __builtin_bit_cast(float, w.y & 0xffff0000u);
                    r1[0] = __builtin_bit_cast(float, w.z << 16); r1[1] = __builtin_bit_cast(float, w.z & 0xffff0000u); r1[2] = __builtin_bit_cast(float, w.w << 16); r1[3] = __builtin_bit_cast(float, w.w & 0xffff0000u);
                    const f32x4 y0 = r0 + acc[ai][bj][m][0], y1 = r1 + acc[ai][bj][m][1];
                    ss += (y0[0] * y0[0] + y0[1] * y0[1]) + (y0[2] * y0[2] + y0[3] * y0[3]) + (y1[0] * y1[0] + y1[1] * y1[1]) + (y1[2] * y1[2] + y1[3] * y1[3]); }
                ss += __builtin_bit_cast(float, __builtin_amdgcn_ds_bpermute((lane ^ 16) << 2, __builtin_bit_cast(int, ss)));
                ss += __builtin_bit_cast(float, __builtin_amdgcn_ds_bpermute((lane ^ 32) << 2, __builtin_bit_cast(int, ss)));
                if (fq == 0) atomicAdd(rss + row, ss);
                asm volatile("" ::: "memory"); }
        asm volatile("s_waitcnt vmcnt(0)" ::: "memory");
        __syncthreads();
        if (wr == 0 && wc == 0 && lane == 0) {
            unsigned* c = cnt + 16 * u.pm;
            __builtin_amdgcn_fence(__ATOMIC_RELEASE, "agent");
            asm volatile("s_waitcnt vmcnt(0)" ::: "memory");
            __hip_atomic_fetch_add(c, 1u, __ATOMIC_RELAXED, __HIP_MEMORY_SCOPE_AGENT);
            unsigned sp = 0;
            while (__hip_atomic_load(c, __ATOMIC_RELAXED, __HIP_MEMORY_SCOPE_AGENT) < (unsigned)ntn) { __builtin_amdgcn_s_sleep(1); if (++sp > (1u << 22)) break; }
            __builtin_amdgcn_fence(__ATOMIC_ACQUIRE, "agent");
            asm volatile("s_waitcnt vmcnt(0)" ::: "memory");
        }
        __syncthreads();
#pragma unroll
        for (int ai = 0; ai < 2; ++ai)
#pragma unroll
            for (int m = 0; m < 4; ++m) { const int row = row0 + ai * HALF + m * 16; const size_t off = (size_t)row * ldc + col0;
                const float sc = __builtin_amdgcn_rsqf(__hip_atomic_load(rss + row, __ATOMIC_RELAXED, __HIP_MEMORY_SCOPE_AGENT) * (1.f / 1024.f) + 1e-6f);
#pragma unroll
                for (int bj = 0; bj < 2; ++bj) { const u32x4 w = *(const u32x4*)(xb + off + bj * HALF);
                    f32x4 r0, r1;
                    r0[0] = __builtin_bit_cast(float, w.x << 16); r0[1] = __builtin_bit_cast(float, w.x & 0xffff0000u); r0[2] = __builtin_bit_cast(float, w.y << 16); r0[3] = __builtin_bit_cast(float, w.y & 0xffff0000u);
                    r1[0] = __builtin_bit_cast(float, w.z << 16); r1[1] = __builtin_bit_cast(float, w.z & 0xffff0000u); r1[2] = __builtin_bit_cast(float, w.w << 16); r1[3] = __builtin_bit_cast(float, w.w & 0xffff0000u);
                    const f32x4 g0 = *(const f32x4*)(g + col0 + bj * HALF), g1 = *(const f32x4*)(g + col0 + bj * HALF + 4);
                    *(f32x4*)(out + off + bj * HALF) = (r0 + acc[ai][bj][m][0]) * sc * g0; *(f32x4*)(out + off + bj * HALF + 4) = (r1 + acc[ai][bj][m][1]) * sc * g1; }
                asm volatile("" ::: "memory"); }
    }
};
struct EpiGU {
    static constexpr bool PERM = true, AFTER_DRAIN = false;
    bf16_t* O; int ldc; const float* rss;
    __device__ __forceinline__ void operator()(const f32x4 (&acc)[2][2][4][2], const Unit& u, int wr, int wc, int fr_, int fq_) const {
        int fr = fr_, fq = fq_; asm volatile("" : "+v"(fr), "+v"(fq));
        const int row0 = u.pm * BM + wr * 64 + fr, col0 = u.pn * HALF + wc * 32 + 8 * fq;
#pragma unroll
        for (int ai = 0; ai < 2; ++ai)
#pragma unroll
            for (int m = 0; m < 4; ++m) { const int row = row0 + ai * HALF + m * 16;
                const float sc = __builtin_amdgcn_rsqf(rss[row] * (1.f / 1024.f) + 1e-6f);
                f32x4 o[2];
#pragma unroll
                for (int n = 0; n < 2; ++n)
#pragma unroll
                    for (int j = 0; j < 4; ++j) { const float g = acc[ai][0][m][n][j] * sc, up = acc[ai][1][m][n][j] * sc;
                        o[n][j] = g * __builtin_amdgcn_rcpf(1.f + __builtin_amdgcn_exp2f(-1.4426950408889634f * g)) * up; }
                *(u32x4*)(O + (size_t)row * ldc + col0) = pack8(o[0], o[1]); asm volatile("" ::: "memory");
            }
    }
};

template <class Epi, class Sched, bool ALIGN_EPI = false, bool SP2 = false>
__device__ __forceinline__ void gemm_phase(PG8_LAS unsigned char* lds, const Gemm g, const Sched& S, const Epi& E, const int tid) {
    const int wid = __builtin_amdgcn_readfirstlane(tid >> 6), lane = tid & 63, wr = wid >> 2, wc = wid & 3, fr = lane & 15, fq = lane >> 4;
    const int K = g.K, nt = K / BK;
    unsigned voffA[2], voffB[2];
#pragma unroll
    for (int i = 0; i < 2; ++i) { int R, C; stage_rc(tid * 16 + i * 8192, R, C); const int Rb = Epi::PERM ? ((R & ~31) + perm32(R & 31)) : R;
        voffA[i] = (unsigned)(R * K + C) * 2u; voffB[i] = (unsigned)(Rb * K + C) * 2u; }
    const size_t kstep = (size_t)(BK * 2);
    const size_t hstep = (size_t)HALF * K * 2;
    const size_t tstep = 2 * hstep;
    const unsigned ldsw = (unsigned)wid * 1024u;
    const int aoff = lds_byte(wr * 64 + fr, fq * 8), boff = lds_byte(wc * 32 + fr, fq * 8);
#define PG8_SA(b, h) (((b) * 2 + (h)) * HTB)
#define PG8_SB(b, h) ((4 + (b) * 2 + (h)) * HTB)
#define PG8_STAGE(bufoff, gbase, voff) do { _Pragma("unroll") for (int _i = 0; _i < 2; ++_i) \
        __builtin_amdgcn_global_load_lds((const unsigned*)((const char*)(gbase) + (voff)[_i]), (PG8_LAS unsigned*)(lds + (bufoff) + ldsw + _i * 8192), 16, 0, 0); } while (0)
#define PG8_LDA(dst, b, h) do { _Pragma("unroll") for (int m = 0; m < 4; ++m) _Pragma("unroll") for (int k = 0; k < 2; ++k) dst[m][k] = *(const PG8_LAS bf16x8*)(lds + PG8_SA(b, h) + aoff + m * 2048 + k * 1024); } while (0)
#define PG8_LDB(dst, b, h) do { _Pragma("unroll") for (int n = 0; n < 2; ++n) _Pragma("unroll") for (int k = 0; k < 2; ++k) dst[n][k] = *(const PG8_LAS bf16x8*)(lds + PG8_SB(b, h) + boff + n * 2048 + k * 1024); } while (0)
#define PG8_MMA(ai, bj, At, Bt) do { __builtin_amdgcn_s_setprio(1); _Pragma("unroll") for (int m = 0; m < 4; ++m) _Pragma("unroll") for (int n = 0; n < 2; ++n) _Pragma("unroll") for (int k = 0; k < 2; ++k) \
        acc[ai][bj][m][n] = __builtin_amdgcn_mfma_f32_16x16x32_bf16(Bt[n][k], At[m][k], acc[ai][bj][m][n], 0, 0, 0); __builtin_amdgcn_s_setprio(0); } while (0)
#define PG8_WAIT_V(n) asm volatile("s_waitcnt vmcnt(" #n ")" ::: "memory")
#define PG8_WAIT_L(n) asm volatile("s_waitcnt lgkmcnt(" #n ")" ::: "memory")
#define PG8_BAR __builtin_amdgcn_s_barrier()
#define PG8_SCHED __builtin_amdgcn_sched_barrier(0)
    Unit cur, nxt; int ui = 0;
    if (!S.next(0, cur)) return;
    f32x4 acc[2][2][4][2];
#pragma unroll
    for (int a = 0; a < 2; ++a)
#pragma unroll
        for (int b = 0; b < 2; ++b)
#pragma unroll
            for (int m = 0; m < 4; ++m)
#pragma unroll
                for (int n = 0; n < 2; ++n) acc[a][b][m][n] = (f32x4){0.f, 0.f, 0.f, 0.f};
    bf16x8 At[4][2], B0[2][2], B1[2][2];
    const char* cA = (const char*)g.A + (size_t)cur.pm * tstep; const char* cB = (const char*)g.Bt + (size_t)cur.pn * tstep;
    S.a_ready(cur);
    if constexpr (SP2) {
        PG8_STAGE(PG8_SB(0, 0), cB, voffB); PG8_STAGE(PG8_SB(0, 1), cB + hstep, voffB); PG8_STAGE(PG8_SA(0, 0), cA, voffA); PG8_STAGE(PG8_SA(0, 1), cA + hstep, voffA);
        if (wr == 1) PG8_BAR;
        PG8_WAIT_V(2); PG8_BAR;
        PG8_STAGE(PG8_SB(1, 0), cB + kstep, voffB); PG8_STAGE(PG8_SA(1, 0), cA + kstep, voffA); PG8_STAGE(PG8_SB(1, 1), cB + hstep + kstep, voffB);
        PG8_WAIT_V(6); PG8_BAR;
    } else {
        PG8_STAGE(PG8_SB(0, 0), cB, voffB); PG8_STAGE(PG8_SA(0, 0), cA, voffA); PG8_STAGE(PG8_SB(0, 1), cB + hstep, voffB); PG8_STAGE(PG8_SA(0, 1), cA + hstep, voffA);
        if (wr == 1) PG8_BAR;
        PG8_WAIT_V(4); PG8_BAR;
        PG8_STAGE(PG8_SB(1, 0), cB + kstep, voffB); PG8_STAGE(PG8_SA(1, 0), cA + kstep, voffA); PG8_STAGE(PG8_SB(1, 1), cB + hstep + kstep, voffB);
        PG8_WAIT_V(6); PG8_BAR;
    }
    for (;;) {
        const bool has_next = S.next(ui + 1, nxt);
        const char* nA = has_next ? (const char*)g.A + (size_t)nxt.pm * tstep : cA; const char* nB = has_next ? (const char*)g.Bt + (size_t)nxt.pn * tstep : cB;
#pragma unroll 1
        for (int t = 0; t < nt; t += 2) {
            const bool last = (t == nt - 2);
            const char* a1 = cA + (size_t)(t + 1) * kstep;
            const char* a2 = last ? nA : cA + (size_t)(t + 2) * kstep; const char* b2 = last ? nB : cB + (size_t)(t + 2) * kstep;
            const char* a3 = a2 + kstep; const char* b3 = b2 + kstep;
            if (last && has_next) S.a_ready(nxt);
            if constexpr (SP2) {
            PG8_LDB(B0, 0, 0); PG8_LDB(B1, 0, 1); PG8_SCHED; PG8_LDA(At, 0, 0); PG8_STAGE(PG8_SA(1, 1), a1 + hstep, voffA);
            PG8_WAIT_V(8); PG8_WAIT_L(0); PG8_BAR; PG8_MMA(0, 0, At, B0); PG8_MMA(0, 1, At, B1); PG8_BAR; PG8_SCHED;
            PG8_LDA(At, 0, 1); PG8_STAGE(PG8_SB(0, 0), b2, voffB); PG8_STAGE(PG8_SB(0, 1), b2 + hstep, voffB); PG8_STAGE(PG8_SA(0, 0), a2, voffA);
            PG8_WAIT_V(8); PG8_WAIT_L(0); PG8_BAR; PG8_MMA(1, 0, At, B0); PG8_MMA(1, 1, At, B1); PG8_BAR; PG8_SCHED;
            PG8_LDB(B0, 1, 0); PG8_LDB(B1, 1, 1); PG8_SCHED; PG8_LDA(At, 1, 0); PG8_STAGE(PG8_SA(0, 1), a2 + hstep, voffA);
            PG8_WAIT_V(8); PG8_WAIT_L(0); PG8_BAR; PG8_MMA(0, 0, At, B0); PG8_MMA(0, 1, At, B1); PG8_BAR; PG8_SCHED;
            PG8_LDA(At, 1, 1); PG8_STAGE(PG8_SB(1, 0), b3, voffB); PG8_STAGE(PG8_SB(1, 1), b3 + hstep, voffB); PG8_STAGE(PG8_SA(1, 0), a3, voffA);
            PG8_WAIT_V(8); PG8_WAIT_L(0); PG8_BAR; PG8_MMA(1, 0, At, B0); PG8_MMA(1, 1, At, B1); PG8_BAR; PG8_SCHED;
            } else {
            PG8_LDB(B0, 0, 0); PG8_SCHED; PG8_LDA(At, 0, 0); PG8_STAGE(PG8_SA(1, 1), a1 + hstep, voffA);
            PG8_WAIT_L(8); PG8_BAR; PG8_WAIT_L(0); PG8_MMA(0, 0, At, B0); PG8_BAR; PG8_SCHED;
            PG8_LDB(B1, 0, 1); PG8_STAGE(PG8_SB(0, 0), b2, voffB);
            PG8_BAR; PG8_WAIT_L(0); PG8_MMA(0, 1, At, B1); PG8_BAR;
            PG8_LDA(At, 0, 1); PG8_STAGE(PG8_SA(0, 0), a2, voffA);
            PG8_BAR; PG8_WAIT_L(0); PG8_MMA(1, 0, At, B0); PG8_BAR; PG8_SCHED;
            PG8_STAGE(PG8_SB(0, 1), b2 + hstep, voffB);
            PG8_WAIT_V(6); PG8_BAR; PG8_MMA(1, 1, At, B1); PG8_BAR;
            PG8_LDB(B0, 1, 0); PG8_SCHED; PG8_LDA(At, 1, 0); PG8_STAGE(PG8_SA(0, 1), a2 + hstep, voffA);
            PG8_WAIT_L(8); PG8_BAR; PG8_WAIT_L(0); PG8_MMA(0, 0, At, B0); PG8_BAR; PG8_SCHED;
            PG8_LDB(B1, 1, 1); PG8_STAGE(PG8_SB(1, 0), b3, voffB);
            PG8_BAR; PG8_WAIT_L(0); PG8_MMA(0, 1, At, B1); PG8_BAR;
            PG8_LDA(At, 1, 1); PG8_STAGE(PG8_SA(1, 0), a3, voffA);
            PG8_BAR; PG8_WAIT_L(0); PG8_MMA(1, 0, At, B0); PG8_BAR; PG8_SCHED;
            PG8_STAGE(PG8_SB(1, 1), b3 + hstep, voffB);
            PG8_WAIT_V(6); PG8_BAR; PG8_MMA(1, 1, At, B1); PG8_BAR;
            }
        }
        if constexpr (ALIGN_EPI) { if (wr == 0) PG8_BAR; }
        if constexpr (!Epi::AFTER_DRAIN) { E(acc, cur, wr, wc, fr, fq); S.done(cur); }
        if (!has_next) break;
#pragma unroll
        for (int a = 0; a < 2; ++a)
#pragma unroll
            for (int b = 0; b < 2; ++b)
#pragma unroll
                for (int m = 0; m < 4; ++m)
#pragma unroll
                    for (int n = 0; n < 2; ++n) acc[a][b][m][n] = (f32x4){0.f, 0.f, 0.f, 0.f};
        cur = nxt; cA = nA; cB = nB; ++ui;
        if constexpr (ALIGN_EPI) { if (wr == 1) PG8_BAR; }
    }
    PG8_WAIT_V(0);
    if constexpr (!ALIGN_EPI) { if (wr == 0) PG8_BAR; }
    PG8_BAR;
    if constexpr (Epi::AFTER_DRAIN) { E.fused(acc, cur, wr, wc, fr, fq, lds, wid, lane); S.done(cur); }
#undef PG8_SA
#undef PG8_SB
#undef PG8_STAGE
#undef PG8_LDA
#undef PG8_LDB
#undef PG8_MMA
#undef PG8_WAIT_V
#undef PG8_WAIT_L
#undef PG8_BAR
#undef PG8_SCHED
}
}

#define LAS __attribute__((address_space(3)))
typedef unsigned short bf16;
typedef short bf16x8 __attribute__((ext_vector_type(8)));
typedef short s16x4 __attribute__((ext_vector_type(4)));
typedef float f32x4 __attribute__((ext_vector_type(4)));
typedef float f32x2 __attribute__((ext_vector_type(2)));
typedef float f32x16 __attribute__((ext_vector_type(16)));
typedef unsigned u32x4 __attribute__((ext_vector_type(4)));
typedef unsigned u32x2 __attribute__((ext_vector_type(2)));
#define LDS_WAIT() asm volatile("s_waitcnt lgkmcnt(0)" ::: "memory")
#define SBAR() __builtin_amdgcn_sched_barrier(0)
__device__ __forceinline__ unsigned cvtpk(float lo, float hi) { unsigned r; asm volatile("v_cvt_pk_bf16_f32 %0, %1, %2" : "=v"(r) : "v"(lo), "v"(hi)); return r; }
__device__ __forceinline__ float bf2f(unsigned short h) { return __builtin_bit_cast(float, (unsigned)h << 16); }
__device__ __forceinline__ float bflo(unsigned w) { return __builtin_bit_cast(float, w << 16); }
__device__ __forceinline__ float bfhi(unsigned w) { return __builtin_bit_cast(float, w & 0xffff0000u); }
__device__ __forceinline__ void unpack8(const u32x4 w, float* f) { f[0] = bflo(w.x); f[1] = bfhi(w.x); f[2] = bflo(w.y); f[3] = bfhi(w.y); f[4] = bflo(w.z); f[5] = bfhi(w.z); f[6] = bflo(w.w); f[7] = bfhi(w.w); }
__device__ __forceinline__ u32x4 pack8f(const float* f) { u32x4 w; w.x = cvtpk(f[0], f[1]); w.y = cvtpk(f[2], f[3]); w.z = cvtpk(f[4], f[5]); w.w = cvtpk(f[6], f[7]); return w; }
__device__ __forceinline__ float shx(float v, int lane, int m) { return __builtin_bit_cast(float, __builtin_amdgcn_ds_bpermute((lane ^ m) << 2, __builtin_bit_cast(int, v))); }
__device__ __forceinline__ float wave_sum(float v, int lane) {
#pragma unroll
    for (int o = 1; o < 64; o <<= 1) v += shx(v, lane, o);
    return v;
}
__device__ __forceinline__ float gelu_tanh(float x) {
    const float y = 0.7978845608028654f * (x + 0.044715f * x * x * x);
    return x * __builtin_amdgcn_rcpf(1.f + __builtin_amdgcn_exp2f(-2.f * 1.4426950408889634f * y));
}

namespace att {
constexpr int NW = 8, QBLK = 32, KVBLK = 64, SEQ = 8192;
constexpr int KROW = 208;
constexpr int SHM_V = KVBLK * 64 * 2, SHM_K = KVBLK * KROW;
constexpr int LDS_V = 0, LDS_K = 3 * SHM_V, LDS_WS = LDS_K + 3 * SHM_K, LDS_BYTES = LDS_WS + NW * 64 * 4;
constexpr float THR2 = 11.5f;
__device__ __forceinline__ int crow(int r, int hi) { return (r & 3) + 8 * (r >> 2) + 4 * hi; }

__device__ __forceinline__ void partialSM(f32x16& p0, f32x16& p1, float& m_reg, float& mn, float& alpha) {
  float pmax = p0[0];
#pragma unroll
  for (int r = 1; r < 16; ++r) pmax = fmaxf(pmax, p0[r]);
#pragma unroll
  for (int r = 0; r < 16; ++r) pmax = fmaxf(pmax, p1[r]);
  { auto rr = __builtin_amdgcn_permlane32_swap(__float_as_uint(pmax), __float_as_uint(pmax), false, false);
    pmax = fmaxf(__uint_as_float(rr[0]), __uint_as_float(rr[1])); }
  if (__builtin_expect(__all(pmax - m_reg <= THR2), 1)) { mn = m_reg; alpha = 1.f; }
  else { mn = fmaxf(m_reg, pmax); alpha = __builtin_amdgcn_exp2f(m_reg - mn); m_reg = mn; }
#pragma unroll
  for (int r = 0; r < 16; ++r) p0[r] = p0[r] - mn;
#pragma unroll
  for (int r = 0; r < 16; ++r) p1[r] = p1[r] - mn;
#pragma unroll
  for (int r = 0; r < 16; ++r) p0[r] = __builtin_amdgcn_exp2f(p0[r]);
}
__device__ __forceinline__ void finishSM(f32x16& p0, f32x16& p1, float alpha, float& l_reg, bf16x8& pa0, bf16x8& pa1, bf16x8& pa2, bf16x8& pa3) {
#pragma unroll
  for (int r = 0; r < 16; ++r) p1[r] = __builtin_amdgcn_exp2f(p1[r]);
  float ps = 0;
#pragma unroll
  for (int r = 0; r < 16; ++r) ps += p0[r];
#pragma unroll
  for (int r = 0; r < 16; ++r) ps += p1[r];
  { auto rr = __builtin_amdgcn_permlane32_swap(__float_as_uint(ps), __float_as_uint(ps), false, false);
    ps = __uint_as_float(rr[0]) + __uint_as_float(rr[1]); }
  l_reg = l_reg * alpha + ps;
#define PK4(P, BASE, OUT) do { unsigned a0 = cvtpk(P[BASE + 0], P[BASE + 1]), a1 = cvtpk(P[BASE + 2], P[BASE + 3]);   \
    unsigned b0 = cvtpk(P[BASE + 4], P[BASE + 5]), b1 = cvtpk(P[BASE + 6], P[BASE + 7]);                              \
    auto r0 = __builtin_amdgcn_permlane32_swap(a0, b0, false, false); auto r1 = __builtin_amdgcn_permlane32_swap(a1, b1, false, false); \
    u32x4 w = {r0[0], r1[0], r0[1], r1[1]}; OUT = *reinterpret_cast<bf16x8*>(&w); } while (0)
  PK4(p0, 0, pa0); PK4(p0, 8, pa1); PK4(p1, 0, pa2); PK4(p1, 8, pa3);
#undef PK4
}
__device__ __forceinline__ void qkt(f32x16& p0, f32x16& p1, const char* Ks, const bf16x8* qr, int r32, int hi) {
  p0 = f32x16{}; p1 = f32x16{};
#pragma unroll
  for (int d0 = 0; d0 < 6; ++d0) { const int cb = d0 * 32 + hi * 16;
    bf16x8 b0 = *reinterpret_cast<const bf16x8*>(Ks + r32 * KROW + cb);
    bf16x8 b1 = *reinterpret_cast<const bf16x8*>(Ks + (32 + r32) * KROW + cb);
    p0 = __builtin_amdgcn_mfma_f32_32x32x16_bf16(b0, qr[d0], p0, 0, 0, 0);
    p1 = __builtin_amdgcn_mfma_f32_32x32x16_bf16(b1, qr[d0], p1, 0, 0, 0); }
}
__device__ __forceinline__ int v_st(int k, int c) { const int kk = (k & ~0xC) | ((k & 4) << 1) | ((k & 8) >> 1); return ((kk >> 3) * 2 + (c >> 5)) * 512 + ((kk & 7) * 32 + (c & 31)) * 2; }
__device__ __forceinline__ int v_rd_base(int lane) { return ((lane & 3) << 3) | (((lane >> 2) & 3) << 6) | (((lane >> 4) & 1) << 5) | (((lane >> 5) & 1) << 8); }
constexpr int v_rd_off(int d0, int ks, int half) { return d0 * 512 + ks * 2048 + half * 1024; }
template <int OFF> __device__ __forceinline__ s16x4 tr_read(int vb) {
  s16x4 r; asm volatile("ds_read_b64_tr_b16 %0, %1 offset:%2" : "=&v"(r) : "v"(vb), "i"(OFF) : "memory"); return r;
}
template <int D0> __device__ __forceinline__ void pv_one(f32x16& od, int vb, bf16x8 pa0, bf16x8 pa1, bf16x8 pa2, bf16x8 pa3) {
  const s16x4 l0 = tr_read<v_rd_off(D0, 0, 0)>(vb), h0 = tr_read<v_rd_off(D0, 0, 1)>(vb), l1 = tr_read<v_rd_off(D0, 1, 0)>(vb), h1 = tr_read<v_rd_off(D0, 1, 1)>(vb);
  const s16x4 l2 = tr_read<v_rd_off(D0, 2, 0)>(vb), h2 = tr_read<v_rd_off(D0, 2, 1)>(vb), l3 = tr_read<v_rd_off(D0, 3, 0)>(vb), h3 = tr_read<v_rd_off(D0, 3, 1)>(vb);
  asm volatile("s_waitcnt lgkmcnt(0)" ::: "memory"); SBAR();
#define PK(L, H) (bf16x8){L[0], L[1], L[2], L[3], H[0], H[1], H[2], H[3]}
  od = __builtin_amdgcn_mfma_f32_32x32x16_bf16(pa0, PK(l0, h0), od, 0, 0, 0);
  od = __builtin_amdgcn_mfma_f32_32x32x16_bf16(pa1, PK(l1, h1), od, 0, 0, 0);
  od = __builtin_amdgcn_mfma_f32_32x32x16_bf16(pa2, PK(l2, h2), od, 0, 0, 0);
  od = __builtin_amdgcn_mfma_f32_32x32x16_bf16(pa3, PK(l3, h3), od, 0, 0, 0);
#undef PK
}
__device__ __forceinline__ void pv_d0(f32x16* o, int vb, bf16x8 pa0, bf16x8 pa1, bf16x8 pa2, bf16x8 pa3) {
  pv_one<0>(o[0], vb, pa0, pa1, pa2, pa3); pv_one<1>(o[1], vb, pa0, pa1, pa2, pa3);
}

typedef short v4i16_t __attribute__((ext_vector_type(4)));
__device__ __forceinline__ s16x4 vtr(const LAS char* p) { return __builtin_bit_cast(s16x4, __builtin_amdgcn_ds_read_tr16_b64_v4i16((LAS v4i16_t*)p)); }
template <int VAR> __device__ __forceinline__ void attn_unit(const bf16* __restrict__ Qb, const bf16* __restrict__ Kh, const bf16* __restrict__ Vh, bf16* __restrict__ Ob, int ldo, char* lds, const int tid, const int rot) {
  const int wid = __builtin_amdgcn_readfirstlane(tid >> 6), lane = tid & 63, r32 = lane & 31, hi = lane >> 5, g = wid >> 2;
  LAS char* ldsl = (LAS char*)lds;
  LAS char* V_lds = ldsl + LDS_V; LAS char* K_lds = ldsl + LDS_K;
  LAS float* ws = (LAS float*)(ldsl + LDS_WS) + wid * 64; LAS float* li_l = ws; LAS float* al_l = ws + 32;
  float m_reg = 0.f, l_reg = 0; f32x16 o[2] = {}; bf16x8 qr[6];
  f32x16 negm = f32x16{};
  const bf16* Qw = Qb + (size_t)(wid * QBLK + r32) * 96 + hi * 8;
#pragma unroll
  for (int d0 = 0; d0 < 6; ++d0) qr[d0] = *reinterpret_cast<const bf16x8*>(Qw + d0 * 16);
  const int kst0 = (tid / 12) * KROW + (tid % 12) * 16, kst1 = ((tid + 512) / 12) * KROW + ((tid + 512) % 12) * 16;
  const int vst = v_st(tid >> 3, (tid & 7) * 8);
  const bool k2 = wid < 4;
  const LAS char* kr = K_lds + r32 * KROW + hi * 16;
  const LAS char* vb = V_lds + v_rd_base(lane);
  const char* Kg = (const char*)Kh + tid * 16; const char* Vg = (const char*)Vh + tid * 16;
  bf16x8 sk0, sk1 = bf16x8{}, sv;
#define TROT(t) ((size_t)(((t) + rot) & (SEQ / KVBLK - 1)))
#define LOADK(t) do { sk0 = *reinterpret_cast<const bf16x8*>(Kg + TROT(t) * (KVBLK * 192)); if (k2) sk1 = *reinterpret_cast<const bf16x8*>(Kg + TROT(t) * (KVBLK * 192) + 8192); } while (0)
#define LOADV(t) do { sv = *reinterpret_cast<const bf16x8*>(Vg + TROT(t) * (KVBLK * 128)); } while (0)
#define WRITEK(b) do { *reinterpret_cast<LAS bf16x8*>(K_lds + (b) * SHM_K + kst0) = sk0; if (k2) *reinterpret_cast<LAS bf16x8*>(K_lds + (b) * SHM_K + kst1) = sk1; } while (0)
#define WRITEV(b) do { *reinterpret_cast<LAS bf16x8*>(V_lds + (b) * SHM_V + vst) = sv; } while (0)
  constexpr int NT = SEQ / KVBLK;
  bf16x8 tk0, tk1 = bf16x8{};
  LOADK(0); LOADV(0);
  tk0 = *reinterpret_cast<const bf16x8*>(Kg + TROT(1) * (KVBLK * 192)); if (k2) tk1 = *reinterpret_cast<const bf16x8*>(Kg + TROT(1) * (KVBLK * 192) + 8192);
  WRITEK(0); WRITEV(0);
  *reinterpret_cast<LAS bf16x8*>(V_lds + 2 * SHM_V + vst) = bf16x8{};
  *reinterpret_cast<LAS bf16x8*>(K_lds + 1 * SHM_K + kst0) = tk0; if (k2) *reinterpret_cast<LAS bf16x8*>(K_lds + 1 * SHM_K + kst1) = tk1;
  LOADK(2); LOADV(1);
  __syncthreads();
  if (g == 1) __syncthreads();
  bf16x8 pa0 = bf16x8{}, pa1 = bf16x8{}, pa2 = bf16x8{}, pa3 = bf16x8{};
  int rk = 0, rv = 2;
#pragma unroll 1
  for (int j = 0; j < NT; ++j) {
    f32x16 s0 = negm, s1 = negm;
    {
      const LAS char* kp = kr + rk * SHM_K; const LAS char* vp = vb + rv * SHM_V;
      bf16x8 ka[6], kb[6];
#pragma unroll
      for (int d0 = 0; d0 < 6; ++d0) { ka[d0] = *reinterpret_cast<const LAS bf16x8*>(kp + d0 * 32); kb[d0] = *reinterpret_cast<const LAS bf16x8*>(kp + 32 * KROW + d0 * 32); }
      s16x4 vl[2][4], vh[2][4];
      __builtin_amdgcn_sched_barrier(0);
#pragma unroll
      for (int d0 = 0; d0 < 2; ++d0) {
        s0 = __builtin_amdgcn_mfma_f32_32x32x16_bf16(ka[d0], qr[d0], s0, 0, 0, 0);
        s1 = __builtin_amdgcn_mfma_f32_32x32x16_bf16(kb[d0], qr[d0], s1, 0, 0, 0); }
      __builtin_amdgcn_sched_barrier(0);
#pragma unroll
      for (int ks = 0; ks < 4; ++ks) { vl[0][ks] = vtr(vp + v_rd_off(0, ks, 0)); vh[0][ks] = vtr(vp + v_rd_off(0, ks, 1)); }
      __builtin_amdgcn_sched_barrier(0);
#pragma unroll
      for (int d0 = 2; d0 < 4; ++d0) {
        s0 = __builtin_amdgcn_mfma_f32_32x32x16_bf16(ka[d0], qr[d0], s0, 0, 0, 0);
        s1 = __builtin_amdgcn_mfma_f32_32x32x16_bf16(kb[d0], qr[d0], s1, 0, 0, 0); }
      __builtin_amdgcn_sched_barrier(0);
#pragma unroll
      for (int ks = 0; ks < 4; ++ks) { vl[1][ks] = vtr(vp + v_rd_off(1, ks, 0)); vh[1][ks] = vtr(vp + v_rd_off(1, ks, 1)); }
      __builtin_amdgcn_sched_barrier(0);
#pragma unroll
      for (int d0 = 4; d0 < 6; ++d0) {
        s0 = __builtin_amdgcn_mfma_f32_32x32x16_bf16(ka[d0], qr[d0], s0, 0, 0, 0);
        s1 = __builtin_amdgcn_mfma_f32_32x32x16_bf16(kb[d0], qr[d0], s1, 0, 0, 0); }
#define PK(L, H) (bf16x8){L[0], L[1], L[2], L[3], H[0], H[1], H[2], H[3]}
      o[0] = __builtin_amdgcn_mfma_f32_32x32x16_bf16(pa0, PK(vl[0][0], vh[0][0]), o[0], 0, 0, 0);
      o[1] = __builtin_amdgcn_mfma_f32_32x32x16_bf16(pa0, PK(vl[1][0], vh[1][0]), o[1], 0, 0, 0);
      o[0] = __builtin_amdgcn_mfma_f32_32x32x16_bf16(pa1, PK(vl[0][1], vh[0][1]), o[0], 0, 0, 0);
      o[1] = __builtin_amdgcn_mfma_f32_32x32x16_bf16(pa1, PK(vl[1][1], vh[1][1]), o[1], 0, 0, 0);
      o[0] = __builtin_amdgcn_mfma_f32_32x32x16_bf16(pa2, PK(vl[0][2], vh[0][2]), o[0], 0, 0, 0);
      o[1] = __builtin_amdgcn_mfma_f32_32x32x16_bf16(pa2, PK(vl[1][2], vh[1][2]), o[1], 0, 0, 0);
      o[0] = __builtin_amdgcn_mfma_f32_32x32x16_bf16(pa3, PK(vl[0][3], vh[0][3]), o[0], 0, 0, 0);
      o[1] = __builtin_amdgcn_mfma_f32_32x32x16_bf16(pa3, PK(vl[1][3], vh[1][3]), o[1], 0, 0, 0);
      if (VAR == 8) __builtin_amdgcn_s_setprio(0);
    }
    if (g == 0) __syncthreads();
    {
      float pmax = s0[0];
      if (VAR != 3 && VAR != 11) {
#pragma unroll
      for (int r = 1; r < 16; ++r) pmax = fmaxf(pmax, s0[r]);
#pragma unroll
      for (int r = 0; r < 16; ++r) pmax = fmaxf(pmax, s1[r]); }
      { auto rr = __builtin_amdgcn_permlane32_swap(__float_as_uint(pmax), __float_as_uint(pmax), false, false);
        pmax = fmaxf(__uint_as_float(rr[0]), __uint_as_float(rr[1])); }
      float alpha = 1.f, ps = 0.f;
      if (__builtin_expect(j > 0 && __all(pmax <= THR2), 1)) {
#pragma unroll
        for (int r = 0; r < 16; ++r) { s0[r] = __builtin_amdgcn_exp2f(s0[r]); ps += s0[r]; }
#pragma unroll
        for (int r = 0; r < 16; ++r) { s1[r] = __builtin_amdgcn_exp2f(s1[r]); ps += s1[r]; }
      } else {
        const float dm = (j == 0) ? pmax : fmaxf(pmax, 0.f);
        alpha = (j == 0) ? 0.f : __builtin_amdgcn_exp2f(-dm);
        m_reg += dm;
#pragma unroll
        for (int r = 0; r < 16; ++r) { s0[r] = __builtin_amdgcn_exp2f(s0[r] - dm); ps += s0[r]; }
#pragma unroll
        for (int r = 0; r < 16; ++r) { s1[r] = __builtin_amdgcn_exp2f(s1[r] - dm); ps += s1[r]; }
#pragma unroll
        for (int r = 0; r < 16; ++r) negm[r] = -m_reg;
      }
      { auto rr = __builtin_amdgcn_permlane32_swap(__float_as_uint(ps), __float_as_uint(ps), false, false);
        ps = __uint_as_float(rr[0]) + __uint_as_float(rr[1]); }
      l_reg = l_reg * alpha + ps;
      if (__any(alpha < 1.f)) { if (hi == 0) al_l[r32] = alpha; asm volatile("s_waitcnt lgkmcnt(0)" ::: "memory");
#pragma unroll
        for (int d = 0; d < 2; ++d)
#pragma unroll
          for (int r = 0; r < 16; ++r) o[d][r] *= al_l[crow(r, hi)]; }
#define PK4(P, BASE, OUT) do { unsigned a0 = cvtpk(P[BASE + 0], P[BASE + 1]), a1 = cvtpk(P[BASE + 2], P[BASE + 3]);   \
    unsigned b0 = cvtpk(P[BASE + 4], P[BASE + 5]), b1 = cvtpk(P[BASE + 6], P[BASE + 7]);                              \
    auto r0 = __builtin_amdgcn_permlane32_swap(a0, b0, false, false); auto r1 = __builtin_amdgcn_permlane32_swap(a1, b1, false, false); \
    u32x4 w = {r0[0], r1[0], r0[1], r1[1]}; OUT = *reinterpret_cast<bf16x8*>(&w); } while (0)
      PK4(s0, 0, pa0); PK4(s0, 8, pa1); PK4(s1, 0, pa2); PK4(s1, 8, pa3);
#undef PK4
      const int nk = j + 2;
      if (VAR != 11) {
        const int wk = (rk == 0) ? 2 : rk - 1;
        const int wv = (rk == 2) ? 0 : rk + 1;
        if (nk - 1 < NT) WRITEV(wv);
        if (nk < NT) { WRITEK(wk); if (VAR != 1) LOADV(nk); }
        if (nk + 1 < NT && VAR != 1) LOADK(nk + 1);
      }
    }
    if (g == 1) __syncthreads();
    rv = rk; rk = (rk == 2) ? 0 : rk + 1;
  }
  {
    const LAS char* vp = vb + ((NT - 1) % 3) * SHM_V;
    s16x4 vl[2][4], vh[2][4];
#pragma unroll
    for (int d0 = 0; d0 < 2; ++d0)
#pragma unroll
      for (int ks = 0; ks < 4; ++ks) { vl[d0][ks] = vtr(vp + v_rd_off(d0, ks, 0)); vh[d0][ks] = vtr(vp + v_rd_off(d0, ks, 1)); }
    o[0] = __builtin_amdgcn_mfma_f32_32x32x16_bf16(pa0, PK(vl[0][0], vh[0][0]), o[0], 0, 0, 0);
    o[1] = __builtin_amdgcn_mfma_f32_32x32x16_bf16(pa0, PK(vl[1][0], vh[1][0]), o[1], 0, 0, 0);
    o[0] = __builtin_amdgcn_mfma_f32_32x32x16_bf16(pa1, PK(vl[0][1], vh[0][1]), o[0], 0, 0, 0);
    o[1] = __builtin_amdgcn_mfma_f32_32x32x16_bf16(pa1, PK(vl[1][1], vh[1][1]), o[1], 0, 0, 0);
    o[0] = __builtin_amdgcn_mfma_f32_32x32x16_bf16(pa2, PK(vl[0][2], vh[0][2]), o[0], 0, 0, 0);
    o[1] = __builtin_amdgcn_mfma_f32_32x32x16_bf16(pa2, PK(vl[1][2], vh[1][2]), o[1], 0, 0, 0);
    o[0] = __builtin_amdgcn_mfma_f32_32x32x16_bf16(pa3, PK(vl[0][3], vh[0][3]), o[0], 0, 0, 0);
    o[1] = __builtin_amdgcn_mfma_f32_32x32x16_bf16(pa3, PK(vl[1][3], vh[1][3]), o[1], 0, 0, 0);
#undef PK
  }
  if (g == 0) __syncthreads();
  if (hi == 0) li_l[r32] = l_reg; asm volatile("s_waitcnt lgkmcnt(0)" ::: "memory");
  float rli[16];
#pragma unroll
  for (int r = 0; r < 16; ++r) rli[r] = __builtin_amdgcn_rcpf(li_l[crow(r, hi)]);
  bf16* Ow = Ob + (size_t)(wid * QBLK) * ldo;
#pragma unroll
  for (int r = 0; r < 16; ++r) { const int orow = crow(r, hi);
#pragma unroll
    for (int d0 = 0; d0 < 2; ++d0) Ow[(size_t)orow * ldo + d0 * 32 + r32] = (bf16)(cvtpk(o[d0][r] * rli[r], 0.f) & 0xffffu); }
  __syncthreads();
#undef LOADK
#undef LOADV
#undef WRITEK
#undef WRITEV
}
}

constexpr int T_ = 32768, SEQ = 8192, NB = 4, NH = 8, DM = 1024, DFF = 2816, DEPTH = 2;
constexpr int NP = 1536;
constexpr float EPS = 1e-6f;
constexpr int O_Q = 0, O_KV = 384, O_KR = 640, O_POOL = 672, O_SGU = 928, O_SGV = 1184;
constexpr size_t MiB = 1u << 20;
constexpr size_t W_IN = 0, W_UQ = W_IN + (size_t)NP * 1024 * 2, W_UKV = W_UQ + (size_t)768 * 384 * 2, W_O = W_UKV + (size_t)1024 * 256 * 2,
                 W_GU = W_O + (size_t)1024 * 1024 * 2, W_DN = W_GU + (size_t)5632 * 1024 * 2, W_S = W_DN + (size_t)1024 * 2816 * 2, W_LAYER = 23 * MiB;
static_assert(W_S + 4 * 128 * 128 * 2 <= W_LAYER, "weight block");
constexpr size_t WS_W = 1 * MiB, WS_ROPE = 48 * MiB, WS_XA = 52 * MiB, WS_HB = 180 * MiB, WS_K = 52 * MiB  , WS_P = 244 * MiB, WS_Q = 244 * MiB,
                 WS_CQ = 340 * MiB, WS_CKV = 364 * MiB, WS_MIX = 380 * MiB, WS_V = 444 * MiB, WS_ACT = 244 * MiB, WS_END = 476 * MiB;
constexpr int LDS_BYTES = 131072 + 1024;
constexpr int N_PHASES = 15;
constexpr size_t WS_RSS = 65536;
constexpr size_t CTL_BYTES = 1 * MiB;

struct Args {
    const float* x; const int* pos; const float* mix_norm; const float* w_in; const float* q_norm; const float* kv_norm; const float* w_uq; const float* w_ukv;
    const float* w_pool; const float* pool_scale; const float* sg_norm; const float* w_s; const float* b_s; const float* w_o; const float* ffn_norm;
    const float* w_gate; const float* w_up; const float* w_down; const float* final_norm; float* out; unsigned char* ws; int ph_lo, ph_hi;
};

template <int MAP> __device__ __forceinline__ int map_row(int c, int extra) {
    if (MAP == 0) return c;
    if (MAP == 1) { const int h = c / 96, j = c - h * 96; if (j < 64) return c; const int i = j - 64; return h * 96 + 64 + 2 * (i & 15) + (i >> 4); }
    return (c >> 7) * 256 + extra * 128 + (c & 127);
}
template <int MAP>
__device__ __forceinline__ void transpose_item(const float* __restrict__ W, int K, int N, bf16* __restrict__ WT, LAS float* scr, int kb, int nb, int lane, int extra, const float* __restrict__ gk = nullptr) {
    const int k0 = 64 * kb, n0 = 32 * nb;
#pragma unroll 8
    for (int i = 0; i < 32; ++i) { const int kk = 2 * i + (lane >> 5); scr[kk * 33 + (lane & 31)] = W[(size_t)(k0 + kk) * N + n0 + (lane & 31)] * (gk ? gk[k0 + kk] : 1.f); }
    LDS_WAIT(); asm volatile("" ::: "memory");
    const int c = lane & 7;
#pragma unroll
    for (int j = 0; j < 4; ++j) { const int n = (lane >> 3) + 8 * j; const LAS float* s = scr + (8 * c) * 33 + n;
        u32x4 o; o.x = cvtpk(s[0 * 33], s[1 * 33]); o.y = cvtpk(s[2 * 33], s[3 * 33]); o.z = cvtpk(s[4 * 33], s[5 * 33]); o.w = cvtpk(s[6 * 33], s[7 * 33]);
        *(u32x4*)(WT + (size_t)map_row<MAP>(n0 + n, extra) * K + k0 + 8 * c) = o; }
    LDS_WAIT(); asm volatile("" ::: "memory");
}
__device__ __forceinline__ void prep_phase(const Args& a, LAS unsigned char* lds, const int tid, const int bx, const int G) {
    const int lane = tid & 63, wave = tid >> 6;
    LAS float* scr = (LAS float*)(lds + wave * 16384);
    const int gw = bx * 8 + wave, NGW = G * 8;
    constexpr int I0 = 16 * 45, I1 = 6 * 24, I2 = 4 * 32, I3 = 12 * 32, I4 = 16 * 88, I5 = I4, I6 = 44 * 32, IL = I0 + I1 + I2 + I3 + I4 + I5 + I6;
    for (int it = gw; it < DEPTH * IL; it += NGW) {
        const int l = it / IL; int r = it - l * IL; unsigned char* wl = a.ws + WS_W + (size_t)l * W_LAYER;
        if (r < I0) { transpose_item<0>(a.w_in + (size_t)l * 1024 * 1440, 1024, 1440, (bf16*)(wl + W_IN), scr, r / 45, r % 45, lane, 0, a.mix_norm + l * 1024); continue; } r -= I0;
        if (r < I1) { transpose_item<1>(a.w_uq + (size_t)l * 384 * 768, 384, 768, (bf16*)(wl + W_UQ), scr, r / 24, r % 24, lane, 0); continue; } r -= I1;
        if (r < I2) { transpose_item<0>(a.w_ukv + (size_t)l * 256 * 1024, 256, 1024, (bf16*)(wl + W_UKV), scr, r / 32, r % 32, lane, 0); continue; } r -= I2;
        if (r < I3) { int kb = r / 32; if (kb >= 8) kb += 4; transpose_item<0>(a.w_o + (size_t)l * 1024 * 1024, 1024, 1024, (bf16*)(wl + W_O), scr, kb, r % 32, lane, 0); continue; } r -= I3;
        if (r < I4) { transpose_item<2>(a.w_gate + (size_t)l * 1024 * 2816, 1024, 2816, (bf16*)(wl + W_GU), scr, r / 88, r % 88, lane, 0, a.ffn_norm + l * 1024); continue; } r -= I4;
        if (r < I5) { transpose_item<2>(a.w_up + (size_t)l * 1024 * 2816, 1024, 2816, (bf16*)(wl + W_GU), scr, r / 88, r % 88, lane, 1, a.ffn_norm + l * 1024); continue; } r -= I5;
        transpose_item<0>(a.w_down + (size_t)l * 2816 * 1024, 2816, 1024, (bf16*)(wl + W_DN), scr, r / 32, r % 32, lane, 0);
    }
    const int gt = bx * 512 + tid, NGT = G * 512;
    for (int i = gt; i < DEPTH * 12288; i += NGT) { const int l = i / 12288, c = i - l * 12288;
        *(u32x4*)(a.ws + WS_W + (size_t)l * W_LAYER + W_IN + (size_t)1440 * 1024 * 2 + (size_t)c * 16) = (u32x4){0u, 0u, 0u, 0u}; }
    for (int i = gt; i < DEPTH * 8192; i += NGT) { const int l = i / 8192, c = i - l * 8192; const float* s = a.w_s + (size_t)l * 65536 + (size_t)c * 8;
        const f32x4 v0 = *(const f32x4*)s, v1 = *(const f32x4*)(s + 4); u32x4 o; o.x = cvtpk(v0[0], v0[1]); o.y = cvtpk(v0[2], v0[3]); o.z = cvtpk(v1[0], v1[1]); o.w = cvtpk(v1[2], v1[3]);
        *(u32x4*)(a.ws + WS_W + (size_t)l * W_LAYER + W_S + (size_t)c * 16) = o; }
    for (int i = gt; i < DEPTH * 32768; i += NGT) { const int l = i >> 15, r = i & 32767, n = r & 1023, g = (r >> 10) & 3, cb = r >> 12;
        const float* wp = a.w_pool + ((size_t)(l * 4 + g) * 64 + cb * 8) * 64; const float* ps = a.pool_scale + l * 256 + g * 64; const float* wo = a.w_o + (size_t)l * 1024 * 1024 + (size_t)(512 + g * 64) * 1024 + n;
        float acc[8] = {0.f, 0.f, 0.f, 0.f, 0.f, 0.f, 0.f, 0.f};
        for (int d = 0; d < 64; ++d) { const float w = ps[d] * wo[(size_t)d * 1024];
#pragma unroll
            for (int e = 0; e < 8; ++e) acc[e] += wp[e * 64 + d] * w; }
        *(u32x4*)(a.ws + WS_W + (size_t)l * W_LAYER + W_O + ((size_t)n * 1024 + 512 + g * 64 + cb * 8) * 2) = pack8f(acc); }
    for (int i = gt; i < T_ * 16; i += NGT) { const int t = i >> 4, p = i & 15;
        const float inv = __builtin_amdgcn_exp2f(-(float)p * (13.287712379549449f / 16.f));
        const double rev = (double)a.pos[t] * (double)inv * 0.15915494309189535;
        const float fr = (float)(rev - __builtin_rint(rev));
        f32x2 cs; cs.x = __builtin_amdgcn_cosf(fr); cs.y = __builtin_amdgcn_sinf(fr);
        *(f32x2*)(a.ws + WS_ROPE + (size_t)i * 8) = cs; }
    for (int m = gw; m < T_; m += NGW) {
        const f32x4* xr = (const f32x4*)(a.x + (size_t)m * DM) + lane; u32x2* o = (u32x2*)((bf16*)(a.ws + WS_HB) + (size_t)m * DM) + lane;
        f32x4 v[4]; float ss = 0.f;
#pragma unroll
        for (int j = 0; j < 4; ++j) { v[j] = xr[64 * j]; ss += (v[j].x * v[j].x + v[j].y * v[j].y) + (v[j].z * v[j].z + v[j].w * v[j].w); }
#pragma unroll
        for (int j = 0; j < 4; ++j) { u32x2 w; w.x = cvtpk(v[j].x, v[j].y); w.y = cvtpk(v[j].z, v[j].w); o[64 * j] = w; }
        ss = wave_sum(ss, lane);
        if (lane == 0) ((float*)(a.ws + WS_RSS))[m] = ss;
    }
}

template <bool F32OUT>
__device__ __forceinline__ void norm_phase(const float* __restrict__ x, const float* __restrict__ g, void* outp, const int tid, const int bx, const int G) {
    const int lane = tid & 63, wave = tid >> 6, gw = bx * 8 + wave, NGW = G * 8;
    f32x4 gv[4];
#pragma unroll
    for (int j = 0; j < 4; ++j) gv[j] = *(const f32x4*)(g + 4 * lane + 256 * j);
    for (int m = gw; m < T_; m += NGW) {
        const f32x4* xr = (const f32x4*)(x + (size_t)m * DM) + lane;
        f32x4 v[4]; float s = 0.f;
#pragma unroll
        for (int j = 0; j < 4; ++j) { v[j] = xr[64 * j]; s += (v[j].x * v[j].x + v[j].y * v[j].y) + (v[j].z * v[j].z + v[j].w * v[j].w); }
        const float r = rsqrtf(wave_sum(s, lane) * (1.f / DM) + EPS);
        if (F32OUT) { f32x4* o = (f32x4*)((float*)outp + (size_t)m * DM) + lane;
#pragma unroll
            for (int j = 0; j < 4; ++j) o[64 * j] = v[j] * r * gv[j];
        } else { u32x2* o = (u32x2*)((bf16*)outp + (size_t)m * DM) + lane;
#pragma unroll
            for (int j = 0; j < 4; ++j) { const f32x4 y = v[j] * r * gv[j]; u32x2 w; w.x = cvtpk(y.x, y.y); w.y = cvtpk(y.z, y.w); o[64 * j] = w; } }
    }
}

constexpr int VT_ROW = 136;
__device__ __forceinline__ void mixprep_phase(const Args& a, int l, char* lds, const int tid, const int bx, const int G) {
    const int lane = tid & 63, wave = __builtin_amdgcn_readfirstlane(tid >> 6);
    const bf16* __restrict__ P = (const bf16*)(a.ws + WS_P); bf16* __restrict__ CQ = (bf16*)(a.ws + WS_CQ); bf16* __restrict__ CKV = (bf16*)(a.ws + WS_CKV); bf16* __restrict__ Kb = (bf16*)(a.ws + WS_K); bf16* __restrict__ MIX = (bf16*)(a.ws + WS_MIX);
    const float* __restrict__ rope = (const float*)(a.ws + WS_ROPE);
    const bf16* Wsb = (const bf16*)(a.ws + WS_W + (size_t)l * W_LAYER + W_S);
    const float* qn = a.q_norm + l * 384; const float* kvn = a.kv_norm + l * 256; const float* sgn = a.sg_norm + l * 256; const float* bs = a.b_s + l * 512;
    float g1[8], g2[8];
#pragma unroll
    for (int e = 0; e < 8; ++e) { g1[e] = lane < 48 ? qn[lane * 8 + e] : kvn[(lane - 48) * 8 + e]; g2[e] = lane < 16 ? kvn[128 + lane * 8 + e] : 0.f; }
    const int cch = tid & 31, gC = cch >> 3, d0C = (cch & 7) * 8;
    float g3[8];
#pragma unroll
    for (int e = 0; e < 8; ++e) g3[e] = sgn[gC * 64 + d0C + e];
    for (int chunk = bx; chunk < T_ / 128; chunk += G) {
        const int t0 = chunk * 128, b = chunk >> 6, s0 = (chunk & 63) * 128;
#pragma unroll 1
        for (int i0 = 0; i0 < 16; i0 += 4) {
          u32x4 c1b[4], c2b[4], rcb[4][2];
          const int pbase_l = (lane & 1) * 8 + ((lane & 2) ? 4 : 0);
#pragma unroll
          for (int u = 0; u < 4; ++u) { const bf16* prow = P + (size_t)(t0 + wave * 16 + i0 + u) * NP;
              c1b[u] = *(const u32x4*)(prow + lane * 8); c2b[u] = *(const u32x4*)(prow + 512 + lane * 8);
              const u32x4* cs = (const u32x4*)(rope + ((size_t)(t0 + wave * 16 + i0 + u) * 16 + pbase_l) * 2); rcb[u][0] = cs[0]; rcb[u][1] = cs[1]; }
#pragma unroll
          for (int u = 0; u < 4; ++u) {
            const int i = i0 + u;
            const int t = t0 + wave * 16 + i, s = s0 + wave * 16 + i;
            const u32x4 c1 = c1b[u]; u32x4 c2 = c2b[u]; if (lane >= 20) c2 = (u32x4){0u, 0u, 0u, 0u};
            float f1[8], f2[8]; unpack8(c1, f1); unpack8(c2, f2);
            float ss1 = 0.f, ss2 = 0.f;
#pragma unroll
            for (int e = 0; e < 8; ++e) { ss1 += f1[e] * f1[e]; ss2 += f2[e] * f2[e]; }
            const float sq = wave_sum(lane < 48 ? ss1 : 0.f, lane), skv = wave_sum((lane >= 48 ? ss1 : 0.f) + (lane < 16 ? ss2 : 0.f), lane);
            const float rq = rsqrtf(sq * (1.f / 384.f) + EPS), rkv = rsqrtf(skv * (1.f / 256.f) + EPS);
            float o1[8], o2[8]; const float r1 = lane < 48 ? rq : rkv;
#pragma unroll
            for (int e = 0; e < 8; ++e) { o1[e] = f1[e] * r1 * g1[e]; o2[e] = f2[e] * rkv * g2[e]; }
            if (lane < 48) *(u32x4*)(CQ + (size_t)t * 384 + lane * 8) = pack8f(o1);
            else *(u32x4*)(CKV + (size_t)t * 256 + (lane - 48) * 8) = pack8f(o1);
            if (lane < 16) *(u32x4*)(CKV + (size_t)t * 256 + 128 + lane * 8) = pack8f(o2);
            const f32x4 fa = {f2[0], f2[1], f2[2], f2[3]}, fb = {f2[4], f2[5], f2[6], f2[7]};
            f32x4 oa, ob;
#pragma unroll
            for (int e = 0; e < 4; ++e) { oa[e] = shx(fa[e], lane, 2); ob[e] = shx(fb[e], lane, 2); }
            if (lane >= 16 && lane < 20) {
                const bool up = (lane & 2) != 0;
                const int pbase = (lane & 1) * 8 + (up ? 4 : 0);
                const f32x4 mine = up ? fb : fa, oth = up ? ob : oa;
                const f32x4 t1 = up ? oth : mine, t2 = up ? mine : oth;
                const f32x4 c01 = __builtin_bit_cast(f32x4, rcb[u][0]), c23 = __builtin_bit_cast(f32x4, rcb[u][1]);
                f32x4 w0, w1;
                w0[0] = t1[0] * c01[0] - t2[0] * c01[1]; w0[1] = t1[0] * c01[1] + t2[0] * c01[0];
                w0[2] = t1[1] * c01[2] - t2[1] * c01[3]; w0[3] = t1[1] * c01[3] + t2[1] * c01[2];
                w1[0] = t1[2] * c23[0] - t2[2] * c23[1]; w1[1] = t1[2] * c23[1] + t2[2] * c23[0];
                w1[2] = t1[3] * c23[2] - t2[3] * c23[3]; w1[3] = t1[3] * c23[3] + t2[3] * c23[2];
                u32x4 pk; pk.x = cvtpk(w0[0], w0[1]); pk.y = cvtpk(w0[2], w0[3]); pk.z = cvtpk(w1[0], w1[1]); pk.w = cvtpk(w1[2], w1[3]);
#pragma unroll
                for (int h = 0; h < NH; ++h) *(u32x4*)(Kb + ((size_t)(b * NH + h) * SEQ + s) * 96 + 64 + 2 * pbase) = pk;
            }
          }
        }
        {
            const int g = wave >> 1, w = 2 << g, left = w >> 1, right = w - 1 - left;
            const int cch = g * 8 + (lane & 7), sf = s0 + (wave & 1) * 64 + (lane >> 3) * 8;
            const bf16* __restrict__ pc = P + (size_t)b * SEQ * NP + O_POOL + cch * 8;
            float acc[8] = {0.f, 0.f, 0.f, 0.f, 0.f, 0.f, 0.f, 0.f};
            for (int k = sf - left; k < sf + right; ++k) if (k >= 0 && k < SEQ) { float f[8]; unpack8(*(const u32x4*)(pc + (size_t)k * NP), f);
#pragma unroll
                for (int e = 0; e < 8; ++e) acc[e] += f[e]; }
            u32x4 ein[8], eout[8], eself[8];
#pragma unroll
            for (int i = 0; i < 8; ++i) { const int kin = sf + i + right, kout = sf + i - left;
                ein[i] = (kin < SEQ) ? *(const u32x4*)(pc + (size_t)kin * NP) : (u32x4){0u, 0u, 0u, 0u};
                eout[i] = (kout >= 0) ? *(const u32x4*)(pc + (size_t)kout * NP) : (u32x4){0u, 0u, 0u, 0u};
                eself[i] = *(const u32x4*)(pc + (size_t)(sf + i) * NP); }
#pragma unroll
            for (int i = 0; i < 8; ++i) {
                const int s = sf + i; const int lo = s - left < 0 ? 0 : s - left, hi = s + right + 1 > SEQ ? SEQ : s + right + 1;
                float fi[8], fo[8], fs[8], d[8]; unpack8(ein[i], fi); unpack8(eout[i], fo); unpack8(eself[i], fs);
                const float inv = 1.f / (float)(hi - lo);
#pragma unroll
                for (int e = 0; e < 8; ++e) { acc[e] += fi[e]; d[e] = acc[e] * inv - fs[e]; acc[e] -= fo[e]; }
                *(u32x4*)(MIX + (size_t)(b * SEQ + s) * DM + 512 + cch * 8) = pack8f(d);
            }
        }
        bf16* vT = (bf16*)lds;
        u32x4 zb[8];
#pragma unroll
        for (int it = 0; it < 8; ++it) zb[it] = *(const u32x4*)(P + (size_t)(t0 + it * 16 + (tid >> 5)) * NP + O_SGV + gC * 64 + d0C);
#pragma unroll
        for (int it = 0; it < 8; ++it) {
            const int tok = it * 16 + (tid >> 5);
            float z[8]; unpack8(zb[it], z);
            float ss = 0.f;
#pragma unroll
            for (int e = 0; e < 8; ++e) { z[e] = gelu_tanh(z[e]); ss += z[e] * z[e]; }
            ss += shx(ss, lane, 1); ss += shx(ss, lane, 2); ss += shx(ss, lane, 4);
            const float r = rsqrtf(ss * (1.f / 64.f) + EPS);
#pragma unroll
            for (int e = 0; e < 8; ++e) vT[(size_t)(gC * 64 + d0C + e) * VT_ROW + tok] = (bf16)(cvtpk(z[e] * r * g3[e], 0.f) & 0xffffu);
        }
        __syncthreads();
        {
            const int g = wave >> 1, ph = (wave & 1) * 64, fr = lane & 15, fq = lane >> 4;
            f32x4 acc[4][4];
#pragma unroll
            for (int m = 0; m < 4; ++m)
#pragma unroll
                for (int n = 0; n < 4; ++n) acc[m][n] = (f32x4){0.f, 0.f, 0.f, 0.f};
#pragma unroll
            for (int kk = 0; kk < 4; ++kk) {
                bf16x8 va[4], wb[4];
#pragma unroll
                for (int m = 0; m < 4; ++m) va[m] = *(const bf16x8*)(vT + (size_t)(g * 64 + m * 16 + fr) * VT_ROW + kk * 32 + fq * 8);
#pragma unroll
                for (int n = 0; n < 4; ++n) wb[n] = *(const bf16x8*)(Wsb + ((size_t)(g * 128 + ph + n * 16 + fr)) * 128 + kk * 32 + fq * 8);
#pragma unroll
                for (int m = 0; m < 4; ++m)
#pragma unroll
                    for (int n = 0; n < 4; ++n) acc[m][n] = __builtin_amdgcn_mfma_f32_16x16x32_bf16(va[m], wb[n], acc[m][n], 0, 0, 0);
            }
#pragma unroll
            for (int n = 0; n < 4; ++n) { const int p = ph + n * 16 + fr; const float bias = bs[g * 128 + p]; const size_t t = (size_t)(t0 + p);
#pragma unroll
                for (int m = 0; m < 4; ++m) { const int d = 16 * m + 4 * fq;
                    const u32x2 uu = *(const u32x2*)(P + t * NP + O_SGU + g * 64 + d);
                    const float u0 = gelu_tanh(bflo(uu.x)), u1 = gelu_tanh(bfhi(uu.x)), u2 = gelu_tanh(bflo(uu.y)), u3 = gelu_tanh(bfhi(uu.y));
                    u32x2 o; o.x = cvtpk(u0 * (acc[m][n][0] + bias), u1 * (acc[m][n][1] + bias)); o.y = cvtpk(u2 * (acc[m][n][2] + bias), u3 * (acc[m][n][3] + bias));
                    *(u32x2*)(MIX + t * DM + 768 + g * 64 + d) = o; } }
        }
        __syncthreads();
    }
}

template <int VAR> __device__ __forceinline__ void attn_phase(const Args& a, char* lds, const int tid, const int bx, const int G) {
    const bf16* Q = (const bf16*)(a.ws + WS_Q); const bf16* Kb = (const bf16*)(a.ws + WS_K); const bf16* Vb = (const bf16*)(a.ws + WS_V); bf16* MIX = (bf16*)(a.ws + WS_MIX);
    for (int i = 0;; ++i) {
        int bh, qb;
        if ((G & 7) == 0) { const int sl = i * (G >> 3) + (bx >> 3); if (sl >= 128) break; bh = (sl >> 5) * 8 + (bx & 7); qb = sl & 31; }
        else { const int u = i * G + bx; if (u >= 1024) break; bh = u >> 5; qb = u & 31; }
        const int b = bh >> 3, h = bh & 7;
        att::attn_unit<VAR>(Q + ((size_t)bh * SEQ + qb * 256) * 96, Kb + (size_t)bh * SEQ * 96, Vb + (size_t)bh * SEQ * 64, MIX + ((size_t)(b * SEQ + qb * 256)) * DM + h * 64, DM, lds, tid, (qb * 4) & 127);
    }
}

#ifndef EN_MASK
#define EN_MASK 0xffff
#endif
#define EN(i) (((EN_MASK) >> (i)) & 1)
template <class Epi> __device__ __forceinline__ void run_gemm(LAS unsigned char* ldsl, const void* A, const void* Bt, int N, int K, const Epi& E, int tid, int bx, int G) {
    asm volatile("" : "+v"(tid));
    pg8::Gemm g{(const pg8::bf16_t*)A, (const pg8::bf16_t*)Bt, T_, N, K}; pg8::StaticOrder S; S.init(T_, N, G, bx);
    pg8::gemm_phase<Epi, pg8::StaticOrder, true, true>(ldsl, g, S, E, tid);
}
#define AS4 __attribute__((address_space(4)))
#ifndef DBL_MASK
#define DBL_MASK 0
#endif
constexpr int dbl_bit(int ph) { return (ph == 0) ? 0 : ((ph - 1) % 7 == 0) ? 2 : ((ph - 1) % 7 == 1) ? 3 : ((ph - 1) % 7 == 2) ? 4 : ((ph - 1) % 7 == 3) ? 6 : ((ph - 1) % 7 == 5) ? 8 : 15; }
#ifndef BAR_REPS
#define BAR_REPS 1
#endif
#ifndef ATT_VAR
#define ATT_VAR 0
#endif
#define DBLP(PH) (((DBL_MASK) >> dbl_bit(PH)) & 1)
template <int PH, int VAR> __device__ __forceinline__ void run_phase(LAS unsigned char* ldsl, unsigned char* lds_raw, const int wave_s) {
    int zv = 0; asm volatile("" : "+v"(zv));
    int tid = wave_s * 64 + (int)__builtin_amdgcn_mbcnt_hi(~0u, __builtin_amdgcn_mbcnt_lo(~0u, (unsigned)zv)); asm volatile("" : "+v"(tid));
    int bx = blockIdx.x, G = gridDim.x, koff = 0; asm volatile("" : "+s"(bx), "+s"(G), "+s"(koff));
#if defined(__HIP_DEVICE_COMPILE__)
    const Args a = *(const AS4 Args*)((const AS4 char*)__builtin_amdgcn_kernarg_segment_ptr() + koff);
#else
    const Args a{};
#endif
    if (PH == 0) { if (EN(0)) prep_phase(a, ldsl, tid, bx, G); }
    else {
        constexpr int l = (PH - 1) / 7, k = (PH - 1) % 7;
        unsigned char* wl = a.ws + WS_W + (size_t)l * W_LAYER;
        float* rss0 = (float*)(a.ws + WS_RSS) + (size_t)(l * 2) * T_; float* rss1 = rss0 + T_;
        if (k == 0) { if (EN(2)) { pg8::EpiStore E{(pg8::bf16_t*)(a.ws + WS_P), NP, rss0}; run_gemm(ldsl, a.ws + WS_HB, wl + W_IN, NP, DM, E, tid, bx, G); } }
        else if (k == 1) { if (EN(3)) mixprep_phase(a, l, (char*)lds_raw, tid, bx, G); }
        else if (k == 2) {
            if (EN(4)) { pg8::EpiQ E{(pg8::bf16_t*)(a.ws + WS_Q), (const float*)(a.ws + WS_ROPE), 0.10206207261596575f * 1.4426950408889634f}; run_gemm(ldsl, a.ws + WS_CQ, wl + W_UQ, 768, 384, E, tid, bx, G); }
            if (EN(5)) { asm volatile("" : "+v"(tid)); pg8::EpiKV E{(pg8::bf16_t*)(a.ws + WS_K), (pg8::bf16_t*)(a.ws + WS_V)}; run_gemm(ldsl, a.ws + WS_CKV, wl + W_UKV, 1024, 256, E, tid, bx, G); }
        }
        else if (k == 3) { if (EN(6)) attn_phase<VAR>(a, (char*)lds_raw, tid, bx, G); }
        else if (k == 4) { if (EN(7)) {
            if (l == 0) { pg8::EpiRes<false, false, true> E{a.x, nullptr, DM, (pg8::bf16_t*)(a.ws + WS_HB), rss1}; run_gemm(ldsl, a.ws + WS_MIX, wl + W_O, DM, DM, E, tid, bx, G); }
            else { pg8::EpiRes<true, false, true> E{nullptr, nullptr, DM, (pg8::bf16_t*)(a.ws + WS_HB), rss1}; run_gemm(ldsl, a.ws + WS_MIX, wl + W_O, DM, DM, E, tid, bx, G); } } }
        else if (k == 5) { if (EN(8)) { pg8::EpiGU E{(pg8::bf16_t*)(a.ws + WS_ACT), DFF, rss1}; run_gemm(ldsl, a.ws + WS_HB, wl + W_GU, 2 * DFF, DM, E, tid, bx, G); } }
        else { if (EN(7)) {
            if (l + 1 < DEPTH) { pg8::EpiRes<true, false, true> E{nullptr, nullptr, DM, (pg8::bf16_t*)(a.ws + WS_HB), rss1 + T_}; run_gemm(ldsl, a.ws + WS_ACT, wl + W_DN, DM, DFF, E, tid, bx, G); }
            else { pg8::EpiFinal E{(const pg8::bf16_t*)(a.ws + WS_HB), a.out, DM, rss1 + T_, (unsigned*)(a.ws + 32768), a.final_norm, DM / 256}; run_gemm(ldsl, a.ws + WS_ACT, wl + W_DN, DM, DFF, E, tid, bx, G); } } }
    }
}
#define XB_TMO      128
#define XB_XCNT(j)  (256  + 64 * (j))
#define XB_XSUB(j)  (1280 + 64 * (j))
#define XB_XGEN(j)  (2304 + 64 * (j))
#define XB_TOP      3328
#define XB_TOPGEN   3392
#define XB_SPIN_CAP (1u << 22)
__device__ __forceinline__ unsigned xb_ld(unsigned* p)              { return __hip_atomic_load(p, __ATOMIC_RELAXED, __HIP_MEMORY_SCOPE_AGENT); }
__device__ __forceinline__ unsigned xb_add(unsigned* p, unsigned v) { return __hip_atomic_fetch_add(p, v, __ATOMIC_RELAXED, __HIP_MEMORY_SCOPE_AGENT); }
__device__ __forceinline__ unsigned xb_xcc_id() { return (unsigned)__builtin_amdgcn_s_getreg((3 << 11) | 20) & 0xFu; }
#define XB_SPIN(cond, bar) do { unsigned _sp = 0; while (cond) { __builtin_amdgcn_s_sleep(1); \
    if ((++_sp & 255u) == 0u) { if (xb_ld(&(bar)[XB_TMO])) break; if (_sp > XB_SPIN_CAP) { atomicAdd(&(bar)[XB_TMO], 1u); break; } } } } while (0)
__device__ __forceinline__ bool is_thread0(const int wave_s) {
    if (wave_s != 0) return false;
    int zv = 0; asm volatile("" : "+v"(zv));
    return __builtin_amdgcn_mbcnt_hi(~0u, __builtin_amdgcn_mbcnt_lo(~0u, (unsigned)zv)) == 0;
}
__device__ __forceinline__ void xcd_barrier_complete(unsigned* bar, unsigned x, unsigned G, unsigned& nloc, unsigned& nx) {
    unsigned sum, cnt, mine, sp = 0u;
    for (;;) {
        sum = 0u; cnt = 0u; mine = 0u;
#pragma unroll
        for (unsigned j = 0; j < 16; ++j) { const unsigned c = xb_ld(&bar[XB_XCNT(j)]); sum += c; cnt += (c > 0u) ? 1u : 0u; mine = (j == x) ? c : mine; }
        if (sum == G) break;
        __builtin_amdgcn_s_sleep(1);
        if ((++sp & 255u) == 0u) { if (xb_ld(&bar[XB_TMO])) break; if (sp > XB_SPIN_CAP) { atomicAdd(&bar[XB_TMO], 1u); break; } }
    }
    nloc = mine > 0u ? mine : 1u; nx = cnt > 0u ? cnt : 1u;
}
__device__ __forceinline__ void grid_barrier(unsigned* bar, const int wave_s, const unsigned x, volatile LAS unsigned* st, const unsigned G) {
    asm volatile("s_waitcnt vmcnt(0)" ::: "memory");
    __syncthreads();
    if (is_thread0(wave_s)) {
        __builtin_amdgcn_s_waitcnt(0);
        unsigned nloc = st[0], nx = st[1];
        if (nloc == 0u) { xcd_barrier_complete(bar, x, G, nloc, nx); st[0] = nloc; st[1] = nx; }
        const unsigned old = xb_add(&bar[XB_XSUB(x)], 1u);
        const unsigned gen = old / nloc;
        if (old + 1u == (gen + 1u) * nloc) {
            __builtin_amdgcn_fence(__ATOMIC_RELEASE, "agent");
            asm volatile("s_waitcnt vmcnt(0)" ::: "memory");
            const unsigned og = xb_add(&bar[XB_TOP], 1u);
            const unsigned tg = og / nx;
            if (og + 1u == (tg + 1u) * nx) xb_add(&bar[XB_TOPGEN], 1u);
            else XB_SPIN(xb_ld(&bar[XB_TOPGEN]) == tg, bar);
            __builtin_amdgcn_fence(__ATOMIC_ACQUIRE, "agent");
            xb_add(&bar[XB_XGEN(x)], 1u);
            asm volatile("s_waitcnt vmcnt(0)" ::: "memory");
        } else {
            XB_SPIN(xb_ld(&bar[XB_XGEN(x)]) == gen, bar);
            __builtin_amdgcn_fence(__ATOMIC_ACQUIRE, "agent");
            asm volatile("s_waitcnt vmcnt(0)" ::: "memory");
        }
    }
    __syncthreads();
}
__global__ void __launch_bounds__(512, 2) fwd(Args ka) {
    extern __shared__ __attribute__((aligned(16))) unsigned char lds_raw[];
    const int lo = ka.ph_lo, hi = ka.ph_hi;
    if (lo < 0) cg::this_grid().sync();
    LAS unsigned char* ldsl = (LAS unsigned char*)lds_raw;
    const int wave_s = __builtin_amdgcn_readfirstlane((int)(threadIdx.x >> 6));
    unsigned* bar = (unsigned*)ka.ws + 4096;
    const unsigned G0 = gridDim.x;
    volatile LAS unsigned* st = (volatile LAS unsigned*)(ldsl + 131072 + 64);
    const unsigned xcc = xb_xcc_id();
    if (is_thread0(wave_s)) { st[0] = 0u; st[1] = 0u; (void)xb_add(&bar[XB_XCNT(xcc)], 1u); }
    __syncthreads();
#define STEP(PH) if (lo <= (PH) && (PH) < hi) { if (DBLP(PH)) { run_phase<PH, ATT_VAR>(ldsl, lds_raw, wave_s); __syncthreads(); } run_phase<PH, 0>(ldsl, lds_raw, wave_s); if ((PH) + 1 < hi) { for (int rep_ = 0; rep_ < BAR_REPS; ++rep_) grid_barrier(bar, wave_s, xcc, st, G0); } }
    STEP(0) STEP(1) STEP(2) STEP(3) STEP(4) STEP(5) STEP(6) STEP(7) STEP(8) STEP(9)
    STEP(10) STEP(11) STEP(12) STEP(13) STEP(14)
#undef STEP
}

extern "C" void kernel_launch(void* const* d_in, const int* in_sizes, int n_in, void* d_out, int out_size, void* d_ws, size_t ws_size, hipStream_t stream) {
    static int grid = 0;
    if (grid == 0) {
        if (n_in != 19 || in_sizes[0] != T_ * DM || out_size != T_ * DM || ws_size < WS_END) {
            fprintf(stderr, "kernel_launch: shape mismatch n_in %d in0 %d out %d ws %zu (need %zu)\n", n_in, n_in > 0 ? in_sizes[0] : -1, out_size, ws_size, (size_t)WS_END); grid = -1; return; }
        int dev = 0, cus = 0, per_cu = 0;
        if (hipGetDevice(&dev) != hipSuccess || hipDeviceGetAttribute(&cus, hipDeviceAttributeMultiprocessorCount, dev) != hipSuccess) { grid = -1; return; }
        if (hipFuncSetAttribute((const void*)fwd, hipFuncAttributeMaxDynamicSharedMemorySize, LDS_BYTES) != hipSuccess) { fprintf(stderr, "kernel_launch: hipFuncSetAttribute failed\n"); grid = -1; return; }
        if (hipOccupancyMaxActiveBlocksPerMultiprocessor(&per_cu, (const void*)fwd, 512, LDS_BYTES) != hipSuccess || per_cu < 1) { fprintf(stderr, "kernel_launch: occupancy query says %d\n", per_cu); per_cu = 1; }
        (void)hipGetLastError();
        grid = cus;
    }
    if (grid < 0) return;
    Args a{};
    a.x = (const float*)d_in[0]; a.pos = (const int*)d_in[1]; a.mix_norm = (const float*)d_in[2]; a.w_in = (const float*)d_in[3]; a.q_norm = (const float*)d_in[4];
    a.kv_norm = (const float*)d_in[5]; a.w_uq = (const float*)d_in[6]; a.w_ukv = (const float*)d_in[7]; a.w_pool = (const float*)d_in[8]; a.pool_scale = (const float*)d_in[9];
    a.sg_norm = (const float*)d_in[10]; a.w_s = (const float*)d_in[11]; a.b_s = (const float*)d_in[12]; a.w_o = (const float*)d_in[13]; a.ffn_norm = (const float*)d_in[14];
    a.w_gate = (const float*)d_in[15]; a.w_up = (const float*)d_in[16]; a.w_down = (const float*)d_in[17]; a.final_norm = (const float*)d_in[18];
    a.out = (float*)d_out; a.ws = (unsigned char*)d_ws;
    if (hipMemsetAsync(d_ws, 0, CTL_BYTES, stream) != hipSuccess) { fprintf(stderr, "kernel_launch: memset failed\n"); return; }
#if MK_MULTI
    for (int ph = 0; ph < N_PHASES; ++ph) { a.ph_lo = ph; a.ph_hi = ph + 1; void* args[] = {&a};
        hipError_t e = hipLaunchCooperativeKernel((const void*)fwd, dim3(grid), dim3(512), args, LDS_BYTES, stream);
        if (e != hipSuccess) { fprintf(stderr, "kernel_launch: launch ph %d failed: %s\n", ph, hipGetErrorString(e)); return; } }
#else
    a.ph_lo = 0; a.ph_hi = N_PHASES; void* args[] = {&a};
    hipError_t e = hipLaunchCooperativeKernel((const void*)fwd, dim3(grid), dim3(512), args, LDS_BYTES, stream);
    if (e != hipSuccess) fprintf(stderr, "kernel_launch: cooperative launch failed: %s (grid %d)\n", hipGetErrorString(e), grid);
#endif
}
```
